# Optimizing an MI355X kernel written in HIP

```python
import math
import jax, jax.numpy as jnp
from jax import lax
import numpy as np

D_MODEL = 1024
BATCH = 8
SEQ = 4096
DEPTH = 2

CTX_LEN = 256
GRID_W = 64
Q_BLOCK = 128
ROPE_THETA = 10000.0
EPS = 1e-6

A_HEAD_DIM = 128
A_HEADS = D_MODEL // (2 * A_HEAD_DIM)
A_KV_HEADS = A_HEADS // 2
A_WIDTH = A_HEADS * A_HEAD_DIM
A_KV_WIDTH = A_KV_HEADS * A_HEAD_DIM
B_HEAD_DIM = 64
B_HEADS = D_MODEL // (4 * B_HEAD_DIM)
B_QK_WIDTH = B_HEADS * 2 * B_HEAD_DIM
B_WIDTH = B_HEADS * 2 * B_HEAD_DIM
ATTN_WIDTH = A_WIDTH + B_WIDTH
KV_COLS = 2 * A_KV_WIDTH + B_QK_WIDTH + B_WIDTH
ATTN_IN_COLS = KV_COLS + A_WIDTH + B_QK_WIDTH + ATTN_WIDTH
F_GROUPS = 4
F_WIDTH = D_MODEL
F_GROUP_DIM = F_WIDTH // F_GROUPS

N_ATTN_LAYERS = (DEPTH + 1) // 2
N_FOURIER_LAYERS = DEPTH // 2

kernel_name = "hybrid_gqa_diffattn_fourier_dit"


def rms_norm(x, g):
    xf = x.astype(jnp.float32)
    y = xf * lax.rsqrt(jnp.mean(xf * xf, axis=-1, keepdims=True) + EPS)
    return (y * g.astype(jnp.float32)).astype(x.dtype)


def modulate(x, g, shift, scale):
    return rms_norm(x, g) * (1 + scale) + shift


def ada_params(cond, w, b):
    m = jax.nn.silu(cond) @ w + b
    return jnp.split(m, 3, axis=-1)


def axial_rope_tables(n_tokens, dim, dtype):
    rows_count = n_tokens // GRID_W
    rows = jnp.repeat(jnp.arange(rows_count, dtype=jnp.float32), GRID_W)
    cols = jnp.tile(jnp.arange(GRID_W, dtype=jnp.float32), rows_count)
    quarter = dim // 4
    inv = ROPE_THETA ** (-jnp.arange(quarter, dtype=jnp.float32) / quarter)
    ang = jnp.stack([rows[:, None] * inv, cols[:, None] * inv], axis=1)
    return jnp.cos(ang).astype(dtype), jnp.sin(ang).astype(dtype)


def apply_axial_rope(x, cos, sin):
    b, n, h, dim = x.shape
    q4 = dim // 4
    xs = x.reshape(b, n, h, 2, 2, q4)
    x1, x2 = xs[..., 0, :], xs[..., 1, :]
    c = cos[None, :, None]
    s = sin[None, :, None]
    out = jnp.stack([x1 * c - x2 * s, x1 * s + x2 * c], axis=-2)
    return out.reshape(x.shape)


def sweep_query_blocks(fn, *qs):
    b, n = qs[0].shape[:2]
    nb = n // Q_BLOCK
    blocks = tuple(jnp.moveaxis(q.reshape(b, nb, Q_BLOCK, *q.shape[2:]), 1, 0) for q in qs)
    out = lax.map(lambda blk: fn(*blk), blocks)
    return jnp.moveaxis(out, 0, 1).reshape(b, n, *out.shape[3:])


def gqa_block(q, k, v):
    b, nq = q.shape[:2]
    qg = q.reshape(b, nq, A_KV_HEADS, A_HEADS // A_KV_HEADS, A_HEAD_DIM)
    s = jnp.einsum('bqkgd,blkd->bkgql', qg, k).astype(jnp.float32) * (A_HEAD_DIM ** -0.5)
    p = jax.nn.softmax(s, axis=-1).astype(v.dtype)
    o = jnp.einsum('bkgql,blkd->bqkgd', p, v)
    return o.reshape(b, nq, A_WIDTH)


def diff_block(q1, q2, k1, k2, v, lam, subln_g, lam_init):
    b, nq = q1.shape[:2]
    scale = B_HEAD_DIM ** -0.5
    p1 = jax.nn.softmax(jnp.einsum('bqhd,blhd->bhql', q1, k1).astype(jnp.float32) * scale, axis=-1)
    p2 = jax.nn.softmax(jnp.einsum('bqhd,blhd->bhql', q2, k2).astype(jnp.float32) * scale, axis=-1)
    p = (p1 - lam * p2).astype(v.dtype)
    o = jnp.einsum('bhql,blhe->bqhe', p, v)
    o = rms_norm(o, subln_g) * (1.0 - lam_init)
    return o.reshape(b, nq, B_WIDTH)


def split_kv(p, kn_g):
    b, n = p.shape[:2]
    kA, vA, kB, vB = jnp.split(p, [A_KV_WIDTH, 2 * A_KV_WIDTH, 2 * A_KV_WIDTH + B_QK_WIDTH], axis=-1)
    kA = rms_norm(kA.reshape(b, n, A_KV_HEADS, A_HEAD_DIM), kn_g)
    vA = vA.reshape(b, n, A_KV_HEADS, A_HEAD_DIM)
    kB = kB.reshape(b, n, B_HEADS, 2, B_HEAD_DIM)
    vB = vB.reshape(b, n, B_HEADS, 2 * B_HEAD_DIM)
    return kA, vA, kB[..., 0, :], kB[..., 1, :], vB


def split_q(p, qn_g):
    b, n = p.shape[:2]
    qA, qB, gate = jnp.split(p, [A_WIDTH, A_WIDTH + B_QK_WIDTH], axis=-1)
    qA = rms_norm(qA.reshape(b, n, A_HEADS, A_HEAD_DIM), qn_g)
    qB = qB.reshape(b, n, B_HEADS, 2, B_HEAD_DIM)
    return qA, qB[..., 0, :], qB[..., 1, :], gate


def attention_layer(x, ctx, mods_x, mods_c, norm_g, w_in, qn_g, kn_g,
                    lam_q1, lam_k1, lam_q2, lam_k2, subln_g, w_out, lam_init, update_ctx):
    shift_x, scale_x, gate_x = mods_x
    shift_c, scale_c, gate_c = mods_c
    hx = modulate(x, norm_g, shift_x, scale_x)
    hc = modulate(ctx, norm_g, shift_c, scale_c)
    lam = (jnp.exp(jnp.sum(lam_q1.astype(jnp.float32) * lam_k1.astype(jnp.float32)))
           - jnp.exp(jnp.sum(lam_q2.astype(jnp.float32) * lam_k2.astype(jnp.float32)))
           + lam_init)

    pc = hc @ (w_in if update_ctx else w_in[:, :KV_COLS])
    kA_c, vA_c, k1_c, k2_c, vB_c = split_kv(pc[..., :KV_COLS], kn_g)

    px = hx @ w_in
    kA_x, vA_x, k1_x, k2_x, vB_x = split_kv(px[..., :KV_COLS], kn_g)
    qA_x, q1_x, q2_x, g_x = split_q(px[..., KV_COLS:], qn_g)
    n = x.shape[1]
    cos_a, sin_a = axial_rope_tables(n, A_HEAD_DIM, x.dtype)
    cos_b, sin_b = axial_rope_tables(n, B_HEAD_DIM, x.dtype)
    qA_x, kA_x = apply_axial_rope(qA_x, cos_a, sin_a), apply_axial_rope(kA_x, cos_a, sin_a)
    q1_x, k1_x = apply_axial_rope(q1_x, cos_b, sin_b), apply_axial_rope(k1_x, cos_b, sin_b)
    q2_x, k2_x = apply_axial_rope(q2_x, cos_b, sin_b), apply_axial_rope(k2_x, cos_b, sin_b)

    def mix(qA, q1, q2, kA, vA, k1, k2, vB):
        def blk(a, b1, b2):
            return jnp.concatenate([gqa_block(a, kA, vA),
                                    diff_block(b1, b2, k1, k2, vB, lam, subln_g, lam_init)], axis=-1)
        return sweep_query_blocks(blk, qA, q1, q2)

    cat = lambda a, b: jnp.concatenate([a, b], axis=1)
    ox = mix(qA_x, q1_x, q2_x, cat(kA_c, kA_x), cat(vA_c, vA_x),
             cat(k1_c, k1_x), cat(k2_c, k2_x), cat(vB_c, vB_x))
    x = x + gate_x * ((ox * jax.nn.silu(g_x)) @ w_out)

    if update_ctx:
        qA_c, q1_c, q2_c, g_c = split_q(pc[..., KV_COLS:], qn_g)
        oc = mix(qA_c, q1_c, q2_c, kA_c, vA_c, k1_c, k2_c, vB_c)
        ctx = ctx + gate_c * ((oc * jax.nn.silu(g_c)) @ w_out)
    return x, ctx


def fourier_layer(x, shift, scale, gate, norm_g, w_in, w_out):
    h = modulate(x, norm_g, shift, scale)
    u, g = jnp.split(h @ w_in, 2, axis=-1)
    b, n = u.shape[:2]
    uf = u.reshape(b, n, F_GROUPS, F_GROUP_DIM).astype(jnp.float32)
    f = jnp.fft.fft2(uf, axes=(1, 3), norm="ortho").real.astype(x.dtype).reshape(b, n, F_WIDTH)
    return x + gate * ((f * jax.nn.silu(g)) @ w_out)


def setup_inputs(seed: int = 0) -> dict:
    key = jax.random.key(seed)
    ks = jax.random.split(key, 24)
    nrm = lambda k, shape: jax.random.normal(k, shape, dtype=jnp.float32)
    D = D_MODEL
    return {
        "x": nrm(ks[0], (BATCH, SEQ, D)),
        "c": nrm(ks[1], (BATCH, D)),
        "ctx": nrm(ks[2], (BATCH, CTX_LEN, D)),
        "c_ctx": nrm(ks[3], (D,)),
        "ada_w": nrm(ks[4], (DEPTH, D, 3 * D)) * (0.5 * D ** -0.5),
        "ada_b": nrm(ks[5], (DEPTH, 3 * D)) * 0.01,
        "norm_g": 1.0 + 0.02 * nrm(ks[6], (DEPTH, D)),
        "attn_in_w": nrm(ks[7], (N_ATTN_LAYERS, D, ATTN_IN_COLS)) * D ** -0.5,
        "attn_qn_g": 1.0 + 0.02 * nrm(ks[8], (N_ATTN_LAYERS, A_HEAD_DIM)),
        "attn_kn_g": 1.0 + 0.02 * nrm(ks[9], (N_ATTN_LAYERS, A_HEAD_DIM)),
        "lam_q1": 0.1 * nrm(ks[10], (N_ATTN_LAYERS, B_HEAD_DIM)),
        "lam_k1": 0.1 * nrm(ks[11], (N_ATTN_LAYERS, B_HEAD_DIM)),
        "lam_q2": 0.1 * nrm(ks[12], (N_ATTN_LAYERS, B_HEAD_DIM)),
        "lam_k2": 0.1 * nrm(ks[13], (N_ATTN_LAYERS, B_HEAD_DIM)),
        "attn_subln_g": 1.0 + 0.02 * nrm(ks[14], (N_ATTN_LAYERS, 2 * B_HEAD_DIM)),
        "attn_out_w": nrm(ks[15], (N_ATTN_LAYERS, ATTN_WIDTH, D)) * ATTN_WIDTH ** -0.5,
        "fourier_in_w": nrm(ks[16], (N_FOURIER_LAYERS, D, 2 * F_WIDTH)) * D ** -0.5,
        "fourier_out_w": nrm(ks[17], (N_FOURIER_LAYERS, F_WIDTH, D)) * F_WIDTH ** -0.5,
        "final_g": 1.0 + 0.02 * nrm(ks[18], (D,)),
    }


def reference(x, c, ctx, c_ctx, ada_w, ada_b, norm_g, attn_in_w, attn_qn_g, attn_kn_g,
              lam_q1, lam_k1, lam_q2, lam_k2, attn_subln_g, attn_out_w,
              fourier_in_w, fourier_out_w, final_g):
    for l in range(DEPTH):
        i = l // 2
        update_ctx = any(j % 2 == 0 for j in range(l + 1, DEPTH))
        mods_x = [m[:, None, :] for m in ada_params(c, ada_w[l], ada_b[l])]
        if l % 2 == 0:
            mods_c = ada_params(c_ctx, ada_w[l], ada_b[l])
            lam_init = 0.8 - 0.6 * math.exp(-0.3 * l)
            x, ctx = attention_layer(x, ctx, mods_x, mods_c, norm_g[l], attn_in_w[i],
                                     attn_qn_g[i], attn_kn_g[i], lam_q1[i], lam_k1[i],
                                     lam_q2[i], lam_k2[i], attn_subln_g[i], attn_out_w[i],
                                     lam_init, update_ctx)
        else:
            x = fourier_layer(x, *mods_x, norm_g[l], fourier_in_w[i], fourier_out_w[i])
            if update_ctx:
                mods_c = ada_params(c_ctx, ada_w[l], ada_b[l])
                ctx = fourier_layer(ctx, *mods_c, norm_g[l], fourier_in_w[i], fourier_out_w[i])
    return rms_norm(x, final_g)
```

```cpp
#include <hip/hip_runtime.h>
#include <hip/hip_cooperative_groups.h>
#include <cstdio>
#include <cstdint>
namespace cg = cooperative_groups;
namespace pg8 {
#define PG8_LAS __attribute__((address_space(3)))
typedef unsigned short bf16_t;
typedef short bf16x8 __attribute__((ext_vector_type(8)));
typedef float f32x4 __attribute__((ext_vector_type(4)));
typedef unsigned u32x4 __attribute__((ext_vector_type(4)));
constexpr int BM = 256, BK = 64, HALF = 128, HTB = HALF * BK * 2  , STAGE_BYTES = 8 * HTB, NXCD = 8, WGM = 8;

__host__ __device__ __forceinline__ int lds_byte(int r, int c) { const int st = (r >> 4) * 2 + (c >> 5), rr = r & 15, cc = c & 31, ob = rr * 64 + cc * 2; return st * 1024 + (ob ^ (((ob >> 9) & 1) << 5)); }
__host__ __device__ __forceinline__ void stage_rc(int b, int& R, int& C) { const int st = b / 1024, sb = b % 1024, swz = sb ^ (((sb >> 9) & 1) << 5); R = (st >> 1) * 16 + swz / 64; C = (st & 1) * 32 + (swz % 64) / 2; }
__host__ __device__ __forceinline__ int perm32(int rho) { const int n = rho >> 4, i = rho & 15; return 8 * (i >> 2) + 4 * n + (i & 3); }

struct Unit { int pm, pn; };
struct Gemm { const bf16_t* A; const bf16_t* Bt; int lda, ldb; int M, N, K; int amask, bshift, bmul, bcap; };

struct StaticOrder {
    int nM, nN, nwg, G, c;
    __host__ __device__ void init(int M, int N, int G_, int c_) { nM = M / BM; nN = N / BM; nwg = nM * nN; G = G_; c = c_; }
    __host__ __device__ bool next(int i, Unit& u) const {
        const long L = (long)i * G + c; if (L >= nwg) return false;
        int wgid = (int)L; { const int q = nwg / NXCD, r = nwg % NXCD, xcd = wgid % NXCD, off = wgid / NXCD; wgid = (xcd < r ? xcd * (q + 1) : r * (q + 1) + (xcd - r) * q) + off; }
        const int nig = WGM * nN, gid = wgid / nig, fm = gid * WGM, gsz = (nM - fm) < WGM ? (nM - fm) : WGM;
        u.pm = fm + ((wgid % nig) % gsz); u.pn = (wgid % nig) / gsz; return true;
    }
    __device__ __forceinline__ void a_ready(const Unit&) const {}
    __device__ __forceinline__ void done(const Unit&) const {}
};

struct OneUnit {
    int pm, pn, valid;
    __host__ __device__ bool next(int i, Unit& u) const { if (i != 0 || !valid) return false; u.pm = pm; u.pn = pn; return true; }
    __device__ __forceinline__ void a_ready(const Unit&) const {}
    __device__ __forceinline__ void done(const Unit&) const {}
};

struct PairOrder {
    int G, c;
    __host__ __device__ bool next(int i, Unit& u) const {
        const int L = (i >> 1) * G + c; if (L >= 256) return false;
        const int which = i & 1, nblk = (L >> 3) & 7, q = (L & 7) + 8 * (L >> 6), b = q >> 2, pn = q & 3;
        u.pm = which * 8 + nblk; u.pn = (b * 2 + which) * 4 + pn; return true;
    }
    __device__ __forceinline__ void a_ready(const Unit&) const {}
    __device__ __forceinline__ void done(const Unit&) const {}
};

__device__ __forceinline__ unsigned cvt_pk_bf16(float lo, float hi) { unsigned r; asm volatile("v_cvt_pk_bf16_f32 %0, %1, %2" : "=v"(r) : "v"(lo), "v"(hi)); return r; }
__device__ __forceinline__ float bflo(unsigned w) { return __uint_as_float(w << 16); }
__device__ __forceinline__ float bfhi(unsigned w) { return __uint_as_float(w & 0xffff0000u); }
__device__ __forceinline__ float silu_f(float x) { return x / (1.f + __expf(-x)); }

struct EpiPlain {
    static constexpr bool PERM = true, AFTER_DRAIN = false;
    bf16_t* O; int ldc;
    __device__ __forceinline__ void operator()(const f32x4 (&acc)[2][2][4][2], const Unit& u, int wr, int wc, int fr, int fq) const {
        const int row0 = u.pm * BM + wr * 64 + fr, col0 = u.pn * BM + wc * 32 + 8 * fq;
#pragma unroll
        for (int ai = 0; ai < 2; ++ai)
#pragma unroll
            for (int m = 0; m < 4; ++m) { bf16_t* rowp = O + (size_t)(row0 + ai * HALF + m * 16) * ldc + col0;
#pragma unroll
                for (int bj = 0; bj < 2; ++bj) { const f32x4 v0 = acc[ai][bj][m][0], v1 = acc[ai][bj][m][1];
                    u32x4 w; w.x = cvt_pk_bf16(v0[0], v0[1]); w.y = cvt_pk_bf16(v0[2], v0[3]); w.z = cvt_pk_bf16(v1[0], v1[1]); w.w = cvt_pk_bf16(v1[2], v1[3]);
                    *(u32x4*)(rowp + bj * HALF) = w; } }
    }
};

struct EpiInProj {
    static constexpr bool PERM = true, AFTER_DRAIN = false;
    bf16_t* KV; bf16_t* PQ;
    __device__ __forceinline__ void operator()(const f32x4 (&acc)[2][2][4][2], const Unit& u, int wr, int wc, int fr, int fq) const {
        const int rit = wr * 64 + fr, cit = wc * 32 + 8 * fq;
        if (u.pn < 6) {
            const int b = u.pm < 128 ? (u.pm >> 4) : (u.pm - 128), key0 = u.pm < 128 ? 256 + (u.pm & 15) * BM : 0;
#pragma unroll
            for (int bj = 0; bj < 2; ++bj) { bf16_t* base = KV + ((size_t)(b * 12 + 2 * u.pn + bj) * 4352 + key0 + rit) * 128 + cit;
#pragma unroll
                for (int ai = 0; ai < 2; ++ai)
#pragma unroll
                    for (int m = 0; m < 4; ++m) { const f32x4 v0 = acc[ai][bj][m][0], v1 = acc[ai][bj][m][1];
                        u32x4 w; w.x = cvt_pk_bf16(v0[0], v0[1]); w.y = cvt_pk_bf16(v0[2], v0[3]); w.z = cvt_pk_bf16(v1[0], v1[1]); w.w = cvt_pk_bf16(v1[2], v1[3]);
                        *(u32x4*)(base + (size_t)(ai * HALF + m * 16) * 128) = w; } }
        } else if (u.pm < 128) {
            bf16_t* base = PQ + (size_t)(u.pm * BM + rit) * 2048 + (u.pn - 6) * BM + cit;
#pragma unroll
            for (int ai = 0; ai < 2; ++ai)
#pragma unroll
                for (int m = 0; m < 4; ++m) { bf16_t* rowp = base + (size_t)(ai * HALF + m * 16) * 2048;
#pragma unroll
                    for (int bj = 0; bj < 2; ++bj) { const f32x4 v0 = acc[ai][bj][m][0], v1 = acc[ai][bj][m][1];
                        u32x4 w; w.x = cvt_pk_bf16(v0[0], v0[1]); w.y = cvt_pk_bf16(v0[2], v0[3]); w.z = cvt_pk_bf16(v1[0], v1[1]); w.w = cvt_pk_bf16(v1[2], v1[3]);
                        *(u32x4*)(rowp + bj * HALF) = w; } }
        }
    }
};

struct EpiResid {
    static constexpr bool PERM = true, AFTER_DRAIN = false;
    const float* resid; float* out; const float* gate;
    __device__ __forceinline__ void operator()(const f32x4 (&acc)[2][2][4][2], const Unit& u, int wr, int wc, int fr, int fq) const {
        const int row0 = u.pm * BM + wr * 64 + fr, col0 = u.pn * BM + wc * 32 + 8 * fq;
        const float* gp = gate + (size_t)((u.pm * BM) >> 12) * 3072 + col0;
        f32x4 gv[2][2];
#pragma unroll
        for (int bj = 0; bj < 2; ++bj)
#pragma unroll
            for (int n = 0; n < 2; ++n) gv[bj][n] = *(const f32x4*)(gp + bj * HALF + 4 * n);
#pragma unroll
        for (int ai = 0; ai < 2; ++ai)
#pragma unroll
            for (int m = 0; m < 4; m += 2) {
                const float* __restrict__ rp = resid; float* __restrict__ op = out; f32x4 r[2][2][2];
#pragma unroll
                for (int mm = 0; mm < 2; ++mm) { const size_t ro = (size_t)(row0 + ai * HALF + (m + mm) * 16) * 1024 + col0;
#pragma unroll
                    for (int bj = 0; bj < 2; ++bj)
#pragma unroll
                        for (int n = 0; n < 2; ++n) r[mm][bj][n] = __builtin_nontemporal_load((const f32x4*)(rp + ro + bj * HALF + 4 * n)); }
#pragma unroll
                for (int mm = 0; mm < 2; ++mm) { const size_t ro = (size_t)(row0 + ai * HALF + (m + mm) * 16) * 1024 + col0;
#pragma unroll
                    for (int bj = 0; bj < 2; ++bj)
#pragma unroll
                        for (int n = 0; n < 2; ++n) *(f32x4*)(op + ro + bj * HALF + 4 * n) = r[mm][bj][n] + gv[bj][n] * acc[ai][bj][m + mm][n]; } }
    }
};


struct EpiFinal {
    static constexpr bool PERM = true, AFTER_DRAIN = false;
    const float* resid; float* out; const float* gate; const float* fg; unsigned* exch; unsigned* cnt; PG8_LAS float* lsc;
    __device__ __forceinline__ void operator()(const f32x4 (&acc_)[2][2][4][2], const Unit& u, int wr, int wc, int fr, int fq) const {
        f32x4 (&acc)[2][2][4][2] = const_cast<f32x4 (&)[2][2][4][2]>(acc_);
        const int tid = threadIdx.x;
        const int row0 = u.pm * BM + wr * 64 + fr, col0 = u.pn * BM + wc * 32 + 8 * fq;
        const float* gp = gate + (size_t)((u.pm * BM) >> 12) * 3072 + col0;
        f32x4 gv[2][2];
#pragma unroll
        for (int bj = 0; bj < 2; ++bj)
#pragma unroll
            for (int n = 0; n < 2; ++n) gv[bj][n] = *(const f32x4*)(gp + bj * HALF + 4 * n);
#pragma unroll
        for (int ai = 0; ai < 2; ++ai)
#pragma unroll
            for (int m = 0; m < 4; ++m) { const size_t ro = (size_t)(row0 + ai * HALF + m * 16) * 1024 + col0; float s = 0.f;
#pragma unroll
                for (int bj = 0; bj < 2; ++bj)
#pragma unroll
                    for (int n = 0; n < 2; ++n) { const f32x4 r = __builtin_nontemporal_load((const f32x4*)(resid + ro + bj * HALF + 4 * n)); const f32x4 v = r + gv[bj][n] * acc[ai][bj][m][n];
                        acc[ai][bj][m][n] = v; s += (v[0] * v[0] + v[1] * v[1]) + (v[2] * v[2] + v[3] * v[3]); }
                s += __shfl_xor(s, 16); s += __shfl_xor(s, 32);
                if (fq == 0) lsc[wc * 256 + ai * HALF + wr * 64 + m * 16 + fr] = s; }
        asm volatile("s_waitcnt lgkmcnt(0)" ::: "memory"); __builtin_amdgcn_s_barrier();
        if (tid < 256) { const float t = (lsc[tid] + lsc[256 + tid]) + (lsc[512 + tid] + lsc[768 + tid]);
            __hip_atomic_store(exch + (size_t)(u.pm * 4 + u.pn) * 256 + tid, __float_as_uint(t), __ATOMIC_RELAXED, __HIP_MEMORY_SCOPE_AGENT); }
        asm volatile("s_waitcnt vmcnt(0) lgkmcnt(0)" ::: "memory"); __builtin_amdgcn_s_barrier();
        if (tid == 0) { __builtin_amdgcn_fence(__ATOMIC_RELEASE, "agent");
            __hip_atomic_fetch_add(cnt + u.pm, 1u, __ATOMIC_RELAXED, __HIP_MEMORY_SCOPE_AGENT);
            unsigned sp = 0; while (__hip_atomic_load(cnt + u.pm, __ATOMIC_RELAXED, __HIP_MEMORY_SCOPE_AGENT) < 4u && ++sp < (1u << 22)) __builtin_amdgcn_s_sleep(1);
            __builtin_amdgcn_fence(__ATOMIC_ACQUIRE, "agent"); asm volatile("s_waitcnt vmcnt(0)" ::: "memory"); }
        __builtin_amdgcn_s_barrier();
        if (tid < 256) { float tot = 0.f;
#pragma unroll
            for (int j = 0; j < 4; ++j) tot += __uint_as_float(__hip_atomic_load(exch + (size_t)(u.pm * 4 + j) * 256 + tid, __ATOMIC_RELAXED, __HIP_MEMORY_SCOPE_AGENT));
            lsc[1024 + tid] = rsqrtf(tot * (1.f / 1024.f) + 1e-6f); }
        asm volatile("s_waitcnt vmcnt(0) lgkmcnt(0)" ::: "memory"); __builtin_amdgcn_s_barrier();
        f32x4 fv[2][2];
#pragma unroll
        for (int bj = 0; bj < 2; ++bj)
#pragma unroll
            for (int n = 0; n < 2; ++n) fv[bj][n] = *(const f32x4*)(fg + col0 + bj * HALF + 4 * n);
#pragma unroll
        for (int ai = 0; ai < 2; ++ai)
#pragma unroll
            for (int m = 0; m < 4; ++m) { const size_t ro = (size_t)(row0 + ai * HALF + m * 16) * 1024 + col0; const float rs = lsc[1024 + ai * HALF + wr * 64 + m * 16 + fr];
#pragma unroll
                for (int bj = 0; bj < 2; ++bj)
#pragma unroll
                    for (int n = 0; n < 2; ++n) *(f32x4*)(out + ro + bj * HALF + 4 * n) = acc[ai][bj][m][n] * rs * fv[bj][n]; }
        asm volatile("s_waitcnt lgkmcnt(0)" ::: "memory"); __builtin_amdgcn_s_barrier();
    }
};

struct EpiFin {
    static constexpr bool PERM = true, AFTER_DRAIN = false;
    bf16_t* Zt; bf16_t* SG;
    __device__ __forceinline__ void operator()(const f32x4 (&acc)[2][2][4][2], const Unit& u, int wr, int wc, int fr, int fq) const {
        const int col0 = u.pn * BM + wc * 32 + 8 * fq;
        if (u.pm < 128) {
            const int which = u.pm >> 6, b = (u.pm & 63) >> 3, n0 = (u.pm & 7) * BM + wr * 64 + fr;
#pragma unroll
            for (int bj = 0; bj < 2; ++bj)
#pragma unroll
                for (int n = 0; n < 2; ++n)
#pragma unroll
                    for (int i = 0; i < 4; ++i) { const int ch = col0 + bj * HALF + 4 * n + i;
                        bf16_t* zp = Zt + ((size_t)((b * 2 + which) * 1024 + ch)) * 2176 + n0;
#pragma unroll
                        for (int ai = 0; ai < 2; ++ai)
#pragma unroll
                            for (int m = 0; m < 4; ++m) zp[ai * HALF + m * 16] = (bf16_t)(cvt_pk_bf16(acc[ai][bj][m][n][i], 0.f) & 0xffffu); }
        } else {
            const int row0 = (u.pm - 128) * BM + wr * 64 + fr;
#pragma unroll
            for (int ai = 0; ai < 2; ++ai)
#pragma unroll
                for (int m = 0; m < 4; ++m) { bf16_t* rowp = SG + (size_t)(row0 + ai * HALF + m * 16) * 1024 + col0;
#pragma unroll
                    for (int bj = 0; bj < 2; ++bj) { const f32x4 v0 = acc[ai][bj][m][0], v1 = acc[ai][bj][m][1];
                        u32x4 w; w.x = cvt_pk_bf16(silu_f(v0[0]), silu_f(v0[1])); w.y = cvt_pk_bf16(silu_f(v0[2]), silu_f(v0[3]));
                        w.z = cvt_pk_bf16(silu_f(v1[0]), silu_f(v1[1])); w.w = cvt_pk_bf16(silu_f(v1[2]), silu_f(v1[3]));
                        *(u32x4*)(rowp + bj * HALF) = w; } }
        }
    }
};

struct EpiDft {
    static constexpr bool PERM = true, AFTER_DRAIN = false;
    const bf16_t* SG; bf16_t* FG; bf16_t* T;
    __device__ __forceinline__ void operator()(const f32x4 (&acc)[2][2][4][2], const Unit& u, int wr, int wc, int fr, int fq) const {
        const int which = u.pm >> 3, b = u.pn >> 3, np0 = (u.pm & 7) * BM + wr * 64 + fr, col0 = (u.pn & 3) * BM + wc * 32 + 8 * fq;
        if (which == 0) {
#pragma unroll
            for (int ai = 0; ai < 2; ++ai)
#pragma unroll
                for (int m = 0; m < 4; ++m) { bf16_t* tp = T + (size_t)(b * 2048 + np0 + ai * HALF + m * 16) * 1024 + col0;
#pragma unroll
                    for (int bj = 0; bj < 2; ++bj) { const f32x4 v0 = acc[ai][bj][m][0], v1 = acc[ai][bj][m][1];
                        u32x4 w; w.x = cvt_pk_bf16(v0[0], v0[1]); w.y = cvt_pk_bf16(v0[2], v0[3]); w.z = cvt_pk_bf16(v1[0], v1[1]); w.w = cvt_pk_bf16(v1[2], v1[3]);
                        *(u32x4*)(tp + bj * HALF) = w; } }
        } else {
#pragma unroll
            for (int ai = 0; ai < 2; ++ai)
#pragma unroll
                for (int m = 0; m < 4; ++m) { const int np = np0 + ai * HALF + m * 16; const bf16_t* __restrict__ tp = T + (size_t)(b * 2048 + np) * 1024 + col0;
                    const size_t r1 = (size_t)(b * 4096 + np) * 1024 + col0, r2 = (size_t)(b * 4096 + 4096 - np) * 1024 + col0;
                    const bf16_t* __restrict__ SGr = SG; bf16_t* __restrict__ FGw = FG;
                    u32x4 twv[2], sv[2], tv[2];
#pragma unroll
                    for (int bj = 0; bj < 2; ++bj) { twv[bj] = *(const u32x4*)(tp + bj * HALF); sv[bj] = __builtin_nontemporal_load((const u32x4*)(SGr + r1 + bj * HALF)); tv[bj] = __builtin_nontemporal_load((const u32x4*)(SGr + (np != 0 ? r2 : r1) + bj * HALF)); }
#pragma unroll
                    for (int bj = 0; bj < 2; ++bj) { const u32x4 tw = twv[bj];
                        const f32x4 a0 = {bflo(tw.x), bfhi(tw.x), bflo(tw.y), bfhi(tw.y)}, a1 = {bflo(tw.z), bfhi(tw.z), bflo(tw.w), bfhi(tw.w)};
                        const f32x4 v0 = a0 - acc[ai][bj][m][0], v1 = a1 - acc[ai][bj][m][1];
                        const u32x4 s = sv[bj];
                        u32x4 w; w.x = cvt_pk_bf16(v0[0] * bflo(s.x), v0[1] * bfhi(s.x)); w.y = cvt_pk_bf16(v0[2] * bflo(s.y), v0[3] * bfhi(s.y));
                        w.z = cvt_pk_bf16(v1[0] * bflo(s.z), v1[1] * bfhi(s.z)); w.w = cvt_pk_bf16(v1[2] * bflo(s.w), v1[3] * bfhi(s.w));
                        *(u32x4*)(FGw + r1 + bj * HALF) = w;
                        if (np != 0) { const f32x4 y0 = a0 + acc[ai][bj][m][0], y1 = a1 + acc[ai][bj][m][1];
                            const u32x4 t = tv[bj];
                            u32x4 x; x.x = cvt_pk_bf16(y0[0] * bflo(t.x), y0[1] * bfhi(t.x)); x.y = cvt_pk_bf16(y0[2] * bflo(t.y), y0[3] * bfhi(t.y));
                            x.z = cvt_pk_bf16(y1[0] * bflo(t.z), y1[1] * bfhi(t.z)); x.w = cvt_pk_bf16(y1[2] * bflo(t.w), y1[3] * bfhi(t.w));
                            *(u32x4*)(FGw + r2 + bj * HALF) = x; } } }
        }
    }
};

template <class Epi, class Sched, bool ALIGN_EPI = false, bool SP2 = false>
__device__ __forceinline__ void gemm_phase(PG8_LAS unsigned char* lds, const Gemm g, const Sched& S, const Epi& E) {
    const int tid = threadIdx.x, wid = __builtin_amdgcn_readfirstlane(tid >> 6), lane = tid & 63, wr = wid >> 2, wc = wid & 3, fr = lane & 15, fq = lane >> 4;
    const int K = g.K, nt = K / BK;
    unsigned voffA[2], voffB[2];
#pragma unroll
    for (int i = 0; i < 2; ++i) { int R, C; stage_rc(tid * 16 + i * 8192, R, C); const int Rb = Epi::PERM ? ((R & ~31) + perm32(R & 31)) : R;
        voffA[i] = (unsigned)(R * g.lda + C) * 2u; voffB[i] = (unsigned)(Rb * g.ldb + C) * 2u; }
    const size_t kstep = (size_t)(BK * 2);
    const size_t hstepA = (size_t)HALF * g.lda * 2, hstepB = (size_t)HALF * g.ldb * 2;
    const size_t tstepA = 2 * hstepA, tstepB = 2 * hstepB;
    const unsigned ldsw = (unsigned)wid * 1024u;
    const int aoff = lds_byte(wr * 64 + fr, fq * 8), boff = lds_byte(wc * 32 + fr, fq * 8);
#define PG8_SA(b, h) (((b) * 2 + (h)) * HTB)
#define PG8_SB(b, h) ((4 + (b) * 2 + (h)) * HTB)
#define PG8_STAGE(bufoff, gbase, voff) do { _Pragma("unroll") for (int _i = 0; _i < 2; ++_i) \
        __builtin_amdgcn_global_load_lds((const unsigned*)((const char*)(gbase) + (voff)[_i]), (PG8_LAS unsigned*)(lds + (bufoff) + ldsw + _i * 8192), 16, 0, 0); } while (0)
#define PG8_LDA(dst, b, h) do { _Pragma("unroll") for (int m = 0; m < 4; ++m) _Pragma("unroll") for (int k = 0; k < 2; ++k) dst[m][k] = *(const PG8_LAS bf16x8*)(lds + PG8_SA(b, h) + aoff + m * 2048 + k * 1024); } while (0)
#define PG8_LDB(dst, b, h) do { _Pragma("unroll") for (int n = 0; n < 2; ++n) _Pragma("unroll") for (int k = 0; k < 2; ++k) dst[n][k] = *(const PG8_LAS bf16x8*)(lds + PG8_SB(b, h) + boff + n * 2048 + k * 1024); } while (0)
#define PG8_MMA(ai, bj, At, Bt) do { __builtin_amdgcn_s_setprio(1); _Pragma("unroll") for (int m = 0; m < 4; ++m) _Pragma("unroll") for (int n = 0; n < 2; ++n) _Pragma("unroll") for (int k = 0; k < 2; ++k) \
        acc[ai][bj][m][n] = __builtin_amdgcn_mfma_f32_16x16x32_bf16(Bt[n][k], At[m][k], acc[ai][bj][m][n], 0, 0, 0); __builtin_amdgcn_s_setprio(0); } while (0)
#define PG8_WAIT_V(n) asm volatile("s_waitcnt vmcnt(" #n ")" ::: "memory")
#define PG8_WAIT_L(n) asm volatile("s_waitcnt lgkmcnt(" #n ")" ::: "memory")
#define PG8_BAR __builtin_amdgcn_s_barrier()
#define PG8_SCHED __builtin_amdgcn_sched_barrier(0)
    Unit cur, nxt; int ui = 0;
    if (!S.next(0, cur)) return;
    f32x4 acc[2][2][4][2];
#pragma unroll
    for (int a = 0; a < 2; ++a)
#pragma unroll
        for (int b = 0; b < 2; ++b)
#pragma unroll
            for (int m = 0; m < 4; ++m)
#pragma unroll
                for (int n = 0; n < 2; ++n) acc[a][b][m][n] = (f32x4){0.f, 0.f, 0.f, 0.f};
    bf16x8 At[4][2], B0[2][2], B1[2][2];
    const char* cA = (const char*)g.A + (size_t)(cur.pm & g.amask) * tstepA; const char* cB = (const char*)g.Bt + (size_t)(cur.pn + min(cur.pm >> g.bshift, g.bcap) * g.bmul) * tstepB;
    S.a_ready(cur);
    if constexpr (SP2) {
        PG8_STAGE(PG8_SB(0, 0), cB, voffB); PG8_STAGE(PG8_SB(0, 1), cB + hstepB, voffB); PG8_STAGE(PG8_SA(0, 0), cA, voffA); PG8_STAGE(PG8_SA(0, 1), cA + hstepA, voffA);
        if (wr == 1) PG8_BAR;
        PG8_WAIT_V(2); PG8_BAR;
        PG8_STAGE(PG8_SB(1, 0), cB + kstep, voffB); PG8_STAGE(PG8_SA(1, 0), cA + kstep, voffA); PG8_STAGE(PG8_SB(1, 1), cB + hstepB + kstep, voffB);
        PG8_WAIT_V(6); PG8_BAR;
    } else {
        PG8_STAGE(PG8_SB(0, 0), cB, voffB); PG8_STAGE(PG8_SA(0, 0), cA, voffA); PG8_STAGE(PG8_SB(0, 1), cB + hstepB, voffB); PG8_STAGE(PG8_SA(0, 1), cA + hstepA, voffA);
        if (wr == 1) PG8_BAR;
        PG8_WAIT_V(4); PG8_BAR;
        PG8_STAGE(PG8_SB(1, 0), cB + kstep, voffB); PG8_STAGE(PG8_SA(1, 0), cA + kstep, voffA); PG8_STAGE(PG8_SB(1, 1), cB + hstepB + kstep, voffB);
        PG8_WAIT_V(6); PG8_BAR;
    }
    for (;;) {
        const bool has_next = S.next(ui + 1, nxt);
        const char* nA = has_next ? (const char*)g.A + (size_t)(nxt.pm & g.amask) * tstepA : cA; const char* nB = has_next ? (const char*)g.Bt + (size_t)(nxt.pn + min(nxt.pm >> g.bshift, g.bcap) * g.bmul) * tstepB : cB;
        for (int t = 0; t < nt; t += 2) {
            const bool last = (t == nt - 2);
            const char* a1 = cA + (size_t)(t + 1) * kstep;
            const char* a2 = last ? nA : cA + (size_t)(t + 2) * kstep; const char* b2 = last ? nB : cB + (size_t)(t + 2) * kstep;
            const char* a3 = a2 + kstep; const char* b3 = b2 + kstep;
            if (last && has_next) S.a_ready(nxt);
            if constexpr (SP2) {
            PG8_LDB(B0, 0, 0); PG8_LDB(B1, 0, 1); PG8_SCHED; PG8_LDA(At, 0, 0); PG8_STAGE(PG8_SA(1, 1), a1 + hstepA, voffA);
            PG8_WAIT_V(8); PG8_WAIT_L(0); PG8_BAR; PG8_MMA(0, 0, At, B0); PG8_MMA(0, 1, At, B1); PG8_BAR; PG8_SCHED;
            PG8_LDA(At, 0, 1); PG8_STAGE(PG8_SB(0, 0), b2, voffB); PG8_STAGE(PG8_SB(0, 1), b2 + hstepB, voffB); PG8_STAGE(PG8_SA(0, 0), a2, voffA);
            PG8_WAIT_V(8); PG8_WAIT_L(0); PG8_BAR; PG8_MMA(1, 0, At, B0); PG8_MMA(1, 1, At, B1); PG8_BAR; PG8_SCHED;
            PG8_LDB(B0, 1, 0); PG8_LDB(B1, 1, 1); PG8_SCHED; PG8_LDA(At, 1, 0); PG8_STAGE(PG8_SA(0, 1), a2 + hstepA, voffA);
            PG8_WAIT_V(8); PG8_WAIT_L(0); PG8_BAR; PG8_MMA(0, 0, At, B0); PG8_MMA(0, 1, At, B1); PG8_BAR; PG8_SCHED;
            PG8_LDA(At, 1, 1); PG8_STAGE(PG8_SB(1, 0), b3, voffB); PG8_STAGE(PG8_SB(1, 1), b3 + hstepB, voffB); PG8_STAGE(PG8_SA(1, 0), a3, voffA);
            PG8_WAIT_V(8); PG8_WAIT_L(0); PG8_BAR; PG8_MMA(1, 0, At, B0); PG8_MMA(1, 1, At, B1); PG8_BAR; PG8_SCHED;
            } else {
            PG8_LDB(B0, 0, 0); PG8_SCHED; PG8_LDA(At, 0, 0); PG8_STAGE(PG8_SA(1, 1), a1 + hstepA, voffA);
            PG8_WAIT_L(8); PG8_BAR; PG8_WAIT_L(0); PG8_MMA(0, 0, At, B0); PG8_BAR; PG8_SCHED;
            PG8_LDB(B1, 0, 1); PG8_STAGE(PG8_SB(0, 0), b2, voffB);
            PG8_BAR; PG8_WAIT_L(0); PG8_MMA(0, 1, At, B1); PG8_BAR;
            PG8_LDA(At, 0, 1); PG8_STAGE(PG8_SA(0, 0), a2, voffA);
            PG8_BAR; PG8_WAIT_L(0); PG8_MMA(1, 0, At, B0); PG8_BAR; PG8_SCHED;
            PG8_STAGE(PG8_SB(0, 1), b2 + hstepB, voffB);
            PG8_WAIT_V(6); PG8_BAR; PG8_MMA(1, 1, At, B1); PG8_BAR;
            PG8_LDB(B0, 1, 0); PG8_SCHED; PG8_LDA(At, 1, 0); PG8_STAGE(PG8_SA(0, 1), a2 + hstepA, voffA);
            PG8_WAIT_L(8); PG8_BAR; PG8_WAIT_L(0); PG8_MMA(0, 0, At, B0); PG8_BAR; PG8_SCHED;
            PG8_LDB(B1, 1, 1); PG8_STAGE(PG8_SB(1, 0), b3, voffB);
            PG8_BAR; PG8_WAIT_L(0); PG8_MMA(0, 1, At, B1); PG8_BAR;
            PG8_LDA(At, 1, 1); PG8_STAGE(PG8_SA(1, 0), a3, voffA);
            PG8_BAR; PG8_WAIT_L(0); PG8_MMA(1, 0, At, B0); PG8_BAR; PG8_SCHED;
            PG8_STAGE(PG8_SB(1, 1), b3 + hstepB, voffB);
            PG8_WAIT_V(6); PG8_BAR; PG8_MMA(1, 1, At, B1); PG8_BAR;
            }
        }
        if constexpr (ALIGN_EPI) { if (wr == 0) PG8_BAR; }
        if constexpr (!Epi::AFTER_DRAIN) { E(acc, cur, wr, wc, fr, fq); S.done(cur); }
        if (!has_next) break;
#pragma unroll
        for (int a = 0; a < 2; ++a)
#pragma unroll
            for (int b = 0; b < 2; ++b)
#pragma unroll
                for (int m = 0; m < 4; ++m)
#pragma unroll
                    for (int n = 0; n < 2; ++n) acc[a][b][m][n] = (f32x4){0.f, 0.f, 0.f, 0.f};
        cur = nxt; cA = nA; cB = nB; ++ui;
        if constexpr (ALIGN_EPI) { if (wr == 1) PG8_BAR; }
    }
    PG8_WAIT_V(0);
    if constexpr (!ALIGN_EPI) { if (wr == 0) PG8_BAR; }
    PG8_BAR;
    if constexpr (Epi::AFTER_DRAIN) { E.fused(acc, cur, wr, wc, fr, fq, lds, wid, lane); S.done(cur); }
#undef PG8_SA
#undef PG8_SB
#undef PG8_STAGE
#undef PG8_LDA
#undef PG8_LDB
#undef PG8_MMA
#undef PG8_WAIT_V
#undef PG8_WAIT_L
#undef PG8_BAR
#undef PG8_SCHED
}
}

namespace att {
typedef unsigned short bf16_t;
using bf16x8 = __attribute__((ext_vector_type(8))) short;
using s16x4  = __attribute__((ext_vector_type(4))) short;
using f32x16 = __attribute__((ext_vector_type(16))) float;
using u32x4  = __attribute__((ext_vector_type(4))) unsigned;
constexpr int   D = 128, NW = 8, QBLK = 32, KVBLK = 64;
constexpr float SCALE = 0.088388347648318440f;
constexpr float THR = 8.f;
constexpr int LDQ = 2048, LDK = 128, LDO = 1536, NKEY = 4352, NT = NKEY / KVBLK;
constexpr size_t SHM_V = KVBLK * D * 2, SHM_K = KVBLK * D * 2, SHM_ATTN = 3 * SHM_V + 3 * SHM_K + NW * 64 * 4;
#define KSWZ(row, colB) ((row) * 256 + ((colB) ^ (((row) & 7) << 4)))
#define SBAR() __builtin_amdgcn_sched_barrier(0)
__device__ __forceinline__ int crow(int r, int hi) { return (r & 3) + 8 * (r >> 2) + 4 * hi; }
__device__ __forceinline__ unsigned cvtpk(float lo, float hi) { unsigned r; asm volatile("v_cvt_pk_bf16_f32 %0, %1, %2" : "=v"(r) : "v"(lo), "v"(hi)); return r; }
__device__ __forceinline__ bf16x8 ld8(const bf16_t* p) { return *reinterpret_cast<const bf16x8*>(p); }

template <bool EXT>
__device__ __forceinline__ void partialSM(f32x16& p0, f32x16& p1, const float mfix) {
  if constexpr (!EXT) {
    constexpr float C = SCALE * 1.4426950408889634f; const float mnC = -mfix * C;
#pragma unroll
    for (int r = 0; r < 16; ++r) p0[r] = fmaf(p0[r], C, mnC);
#pragma unroll
    for (int r = 0; r < 16; ++r) p1[r] = fmaf(p1[r], C, mnC);
  }
#pragma unroll
  for (int r = 0; r < 16; ++r) p0[r] = __builtin_amdgcn_exp2f(p0[r]);
}
template <bool VSUM>
__device__ __forceinline__ void finishSM(f32x16& p0, f32x16& p1, float alpha, float& l_reg, bf16x8& pa0, bf16x8& pa1, bf16x8& pa2, bf16x8& pa3) {
#pragma unroll
  for (int r = 0; r < 16; ++r) p1[r] = __builtin_amdgcn_exp2f(p1[r]);
  if constexpr (VSUM) {
  float ps = 0;
#pragma unroll
  for (int r = 0; r < 16; ++r) ps += p0[r];
#pragma unroll
  for (int r = 0; r < 16; ++r) ps += p1[r];
  { auto rr = __builtin_amdgcn_permlane32_swap(__float_as_uint(ps), __float_as_uint(ps), false, false);
    ps = __uint_as_float(rr[0]) + __uint_as_float(rr[1]); }
  l_reg = l_reg * alpha + ps;
  }
#define PK4(P, BASE, OUT) do { unsigned a0 = cvtpk(P[BASE + 0], P[BASE + 1]), a1 = cvtpk(P[BASE + 2], P[BASE + 3]);   \
    unsigned b0 = cvtpk(P[BASE + 4], P[BASE + 5]), b1 = cvtpk(P[BASE + 6], P[BASE + 7]);                              \
    auto r0 = __builtin_amdgcn_permlane32_swap(a0, b0, false, false); auto r1 = __builtin_amdgcn_permlane32_swap(a1, b1, false, false); \
    u32x4 w = {r0[0], r1[0], r0[1], r1[1]}; OUT = *reinterpret_cast<bf16x8*>(&w); } while (0)
  PK4(p0, 0, pa0); PK4(p0, 8, pa1); PK4(p1, 0, pa2); PK4(p1, 8, pa3);
#undef PK4
}
template <int ND0, bool EXT>
__device__ __forceinline__ void qkt(f32x16& p0, f32x16& p1, const char* Ks, const bf16x8* qr, int r32, int hi, const bf16x8 kx, const bf16x8 qx) {
  if constexpr (EXT) { p0 = __builtin_amdgcn_mfma_f32_32x32x16_bf16(kx, qx, f32x16{}, 0, 0, 0);
    p1 = __builtin_amdgcn_mfma_f32_32x32x16_bf16(kx, qx, f32x16{}, 0, 0, 0); }
  else { p0 = f32x16{}; p1 = f32x16{}; }
#pragma unroll
  for (int d0 = 0; d0 < ND0; ++d0) { int cb = (d0 * 16 + hi * 8) * 2;
    bf16x8 b0 = *reinterpret_cast<const bf16x8*>(Ks + KSWZ(r32, cb));
    bf16x8 b1 = *reinterpret_cast<const bf16x8*>(Ks + KSWZ(32 + r32, cb));
    p0 = __builtin_amdgcn_mfma_f32_32x32x16_bf16(b0, qr[d0], p0, 0, 0, 0);
    p1 = __builtin_amdgcn_mfma_f32_32x32x16_bf16(b1, qr[d0], p1, 0, 0, 0); }
}
__device__ __forceinline__ int v_st(int k, int c) { const int kk = (k & ~0xC) | ((k & 4) << 1) | ((k & 8) >> 1); return ((kk >> 3) * 4 + (c >> 5)) * 512 + ((kk & 7) * 32 + (c & 31)) * 2; }
__device__ __forceinline__ int v_rd_base(int lane) { return ((lane & 3) << 3) | (((lane >> 2) & 3) << 6) | (((lane >> 4) & 1) << 5) | (((lane >> 5) & 1) << 8); }
constexpr int v_rd_off(int d0, int ks, int half) { return d0 * 512 + ks * 4096 + half * 2048; }
template <int OFF> __device__ __forceinline__ s16x4 tr_read(int vb) {
  s16x4 r; asm volatile("ds_read_b64_tr_b16 %0, %1 offset:%2" : "=&v"(r) : "v"(vb), "i"(OFF) : "memory"); return r;
}
template <int KS> __device__ __forceinline__ void pv_ks(f32x16* o, int vb, bf16x8 pa) {
  const s16x4 l0 = tr_read<v_rd_off(0, KS, 0)>(vb), h0 = tr_read<v_rd_off(0, KS, 1)>(vb), l1 = tr_read<v_rd_off(1, KS, 0)>(vb), h1 = tr_read<v_rd_off(1, KS, 1)>(vb);
  const s16x4 l2 = tr_read<v_rd_off(2, KS, 0)>(vb), h2 = tr_read<v_rd_off(2, KS, 1)>(vb), l3 = tr_read<v_rd_off(3, KS, 0)>(vb), h3 = tr_read<v_rd_off(3, KS, 1)>(vb);
  asm volatile("s_waitcnt lgkmcnt(0)" ::: "memory"); SBAR();
#define PK(L, H) (bf16x8){L[0], L[1], L[2], L[3], H[0], H[1], H[2], H[3]}
  o[0] = __builtin_amdgcn_mfma_f32_32x32x16_bf16(pa, PK(l0, h0), o[0], 0, 0, 0);
  o[1] = __builtin_amdgcn_mfma_f32_32x32x16_bf16(pa, PK(l1, h1), o[1], 0, 0, 0);
  o[2] = __builtin_amdgcn_mfma_f32_32x32x16_bf16(pa, PK(l2, h2), o[2], 0, 0, 0);
  o[3] = __builtin_amdgcn_mfma_f32_32x32x16_bf16(pa, PK(l3, h3), o[3], 0, 0, 0);
#undef PK
}
__device__ __forceinline__ void pv_d0(f32x16* o, int vb, bf16x8 pa0, bf16x8 pa1, bf16x8 pa2, bf16x8 pa3) {
  pv_ks<0>(o, vb, pa0); pv_ks<1>(o, vb, pa1); pv_ks<2>(o, vb, pa2); pv_ks<3>(o, vb, pa3);
}
__device__ __forceinline__ float bf2f(short h) { return __uint_as_float(((unsigned)(unsigned short)h) << 16); }

template <bool ISB>
__device__ __forceinline__ void attn_unit(const bf16_t* __restrict__ P, const bf16_t* __restrict__ KV, bf16_t* __restrict__ O, bf16_t* __restrict__ OG, const float lam, const float* __restrict__ subln_g, int b, int vh, int qb,
                                          const float* __restrict__ qn_g, const float2* __restrict__ ropeA, const float2* __restrict__ ropeB, const unsigned* KM, char* lds) {
  constexpr int ND0 = ISB ? 4 : 8;
  int tid_ = threadIdx.x; asm volatile("" : "+v"(tid_));
  const int tid = tid_, wid = tid >> 6, lane = tid & 63, r32 = lane & 31, hi = lane >> 5;
  char* V_lds = lds; char* K_lds = lds + 3 * SHM_V;
  float* ws = (float*)(lds + 3 * SHM_V + 3 * SHM_K) + wid * 64; float* li_l = ws; float* al_l = ws + 32;
  int qcol, kcol, vcol, koffB = 0;
  int kslot, vslot;
  if constexpr (ISB) { const int h = (vh - 4) >> 1, t = (vh - 4) & 1; qcol = 512 + h * 128 + t * 64; kslot = 4 + h; vslot = 8 + h; koffB = t * 128; }
  else { const int kvh = vh >> 1; qcol = vh * 128; kslot = kvh; vslot = 2 + kvh; }
  kcol = 0; vcol = 0;
  const bf16_t* Kc = KV + (size_t)(b * 12 + kslot) * 4352 * 128; const bf16_t* Vc = KV + (size_t)(b * 12 + vslot) * 4352 * 128;
  const float kmax2 = __uint_as_float(KM[b * 16 + (ISB ? 2 + (vh - 4) : (vh >> 1))]);
  float l_reg = 0; f32x16 o[4] = {}; bf16x8 qr[ND0]; float mfix; bool usefix;
  {
    const int pos = qb * 256 + wid * QBLK + r32, prow = pos >> 6, pcol = pos & 63;
    const bf16_t* Qw = P + (size_t)(b * 4096 + pos) * LDQ + qcol + hi * 8;
    float qf[ND0][8];
#pragma unroll
    for (int d0 = 0; d0 < ND0; ++d0) { const bf16x8 raw = __builtin_nontemporal_load(reinterpret_cast<const bf16x8*>(Qw + d0 * 16));
#pragma unroll
      for (int i = 0; i < 8; ++i) qf[d0][i] = bf2f(raw[i]); }
    if constexpr (!ISB) {
      float ss = 0.f;
#pragma unroll
      for (int d0 = 0; d0 < 8; ++d0)
#pragma unroll
        for (int i = 0; i < 8; ++i) ss += qf[d0][i] * qf[d0][i];
      { auto rr = __builtin_amdgcn_permlane32_swap(__float_as_uint(ss), __float_as_uint(ss), false, false);
        ss = __uint_as_float(rr[0]) + __uint_as_float(rr[1]); }
      const float rstd = rsqrtf(ss * (1.f / 128.f) + 1e-6f);
#pragma unroll
      for (int d0 = 0; d0 < 8; ++d0)
#pragma unroll
        for (int i = 0; i < 8; ++i) qf[d0][i] *= rstd * qn_g[d0 * 16 + hi * 8 + i];
#pragma unroll
      for (int ax = 0; ax < 2; ++ax) { const int pa = ax ? pcol : prow;
#pragma unroll
        for (int e = 0; e < 2; ++e) { const int dl = ax * 4 + e, dh = dl + 2;
#pragma unroll
          for (int i = 0; i < 8; ++i) { const float2 cs = ropeA[pa * 32 + e * 16 + hi * 8 + i]; const float x1 = qf[dl][i], x2 = qf[dh][i];
            qf[dl][i] = x1 * cs.x - x2 * cs.y; qf[dh][i] = x1 * cs.y + x2 * cs.x; } } }
    } else {
#pragma unroll
      for (int ax = 0; ax < 2; ++ax) { const int pa = ax ? pcol : prow; const int dl = ax * 2, dh = dl + 1;
#pragma unroll
        for (int i = 0; i < 8; ++i) { const float2 cs = ropeB[pa * 16 + hi * 8 + i]; const float x1 = qf[dl][i] * 1.41421356237f, x2 = qf[dh][i] * 1.41421356237f;
          qf[dl][i] = x1 * cs.x - x2 * cs.y; qf[dh][i] = x1 * cs.y + x2 * cs.x; } }
    }
    constexpr float CQ = ISB ? SCALE * 1.4426950408889634f : 1.f;
#pragma unroll
    for (int d0 = 0; d0 < ND0; ++d0) { u32x4 w = {cvtpk(qf[d0][0] * CQ, qf[d0][1] * CQ), cvtpk(qf[d0][2] * CQ, qf[d0][3] * CQ), cvtpk(qf[d0][4] * CQ, qf[d0][5] * CQ), cvtpk(qf[d0][6] * CQ, qf[d0][7] * CQ)};
      qr[d0] = *reinterpret_cast<bf16x8*>(&w); }
    float nq2 = 0.f;
#pragma unroll
    for (int d0 = 0; d0 < ND0; ++d0)
#pragma unroll
      for (int i = 0; i < 8; ++i) nq2 += qf[d0][i] * qf[d0][i];
    { auto rr = __builtin_amdgcn_permlane32_swap(__float_as_uint(nq2), __float_as_uint(nq2), false, false);
      nq2 = __uint_as_float(rr[0]) + __uint_as_float(rr[1]); }
    mfix = sqrtf(nq2 * kmax2) * 1.02f + 0.1f;
    usefix = __all(mfix * SCALE <= 40.f);
    mfix *= CQ;
  }
  if (!usefix) {
    float mx = -3.0e38f;
    for (int j = 0; j < NT; ++j) {
      const bf16_t* rb_ = Kc + (size_t)(j * KVBLK) * LDK + (koffB >> 1) + hi * 8;
      f32x16 s0 = {}, s1 = {};
#pragma unroll
      for (int d0 = 0; d0 < ND0; ++d0) { const bf16x8 b0 = ld8(rb_ + (size_t)r32 * LDK + d0 * 16), b1 = ld8(rb_ + (size_t)(32 + r32) * LDK + d0 * 16);
        s0 = __builtin_amdgcn_mfma_f32_32x32x16_bf16(b0, qr[d0], s0, 0, 0, 0); s1 = __builtin_amdgcn_mfma_f32_32x32x16_bf16(b1, qr[d0], s1, 0, 0, 0); }
#pragma unroll
      for (int r = 0; r < 16; ++r) mx = fmaxf(mx, fmaxf(s0[r], s1[r]));
    }
    { auto rr = __builtin_amdgcn_permlane32_swap(__float_as_uint(mx), __float_as_uint(mx), false, false); mx = fmaxf(__uint_as_float(rr[0]), __uint_as_float(rr[1])); }
    mfix = mx;
  }
  bf16x8 kx, qx, ones; f32x16 o5 = {};
  { u32x4 w = {hi == 0 ? 0x3F80u : 0u, 0u, 0u, 0u}; kx = *reinterpret_cast<bf16x8*>(&w); u32x4 w2 = {hi == 0 ? (cvtpk(-mfix, 0.f) & 0xffffu) : 0u, 0u, 0u, 0u}; qx = *reinterpret_cast<bf16x8*>(&w2);
    u32x4 w1 = {0x3F803F80u, 0x3F803F80u, 0x3F803F80u, 0x3F803F80u}; ones = *reinterpret_cast<bf16x8*>(&w1); }
#define RSUM() do { if constexpr (ISB) { o5 = __builtin_amdgcn_mfma_f32_32x32x16_bf16(pa0, ones, o5, 0, 0, 0); o5 = __builtin_amdgcn_mfma_f32_32x32x16_bf16(pa1, ones, o5, 0, 0, 0); \
    o5 = __builtin_amdgcn_mfma_f32_32x32x16_bf16(pa2, ones, o5, 0, 0, 0); o5 = __builtin_amdgcn_mfma_f32_32x32x16_bf16(pa3, ones, o5, 0, 0, 0); } } while (0)
  const int sr = tid >> 4, sc = (tid & 15) * 8, vst0 = v_st(sr, sc), vst1 = v_st(32 + sr, sc);
  const int vb0 = (int)(uintptr_t)V_lds + v_rd_base(lane);
  const char* Kb = K_lds + koffB;
  struct { bf16x8 vs0, vs1, ks0, ks1; } sr_[2];
  const int ksr = tid >> 3, ksc = (tid & 7) * 8 + (koffB >> 1);
#define SLOAD(i, k0) do { const bf16_t* vb_ = Vc + (size_t)(k0) * LDK; const bf16_t* kb_ = Kc + (size_t)(k0) * LDK; sr_[i].vs0 = ld8(vb_ + (size_t)sr * LDK + sc); sr_[i].vs1 = ld8(vb_ + (size_t)(32 + sr) * LDK + sc); \
    if constexpr (ISB) { sr_[i].ks0 = ld8(kb_ + (size_t)ksr * LDK + ksc); } \
    else { sr_[i].ks0 = ld8(kb_ + (size_t)sr * LDK + sc); sr_[i].ks1 = ld8(kb_ + (size_t)(32 + sr) * LDK + sc); } } while (0)
#define SWRITE(bb, i) do { *(bf16x8*)(V_lds + (bb) * SHM_V + vst0) = sr_[i].vs0;          \
    *(bf16x8*)(V_lds + (bb) * SHM_V + vst1) = sr_[i].vs1; int kc = sc * 2;               \
    if constexpr (ISB) { *(bf16x8*)(K_lds + (bb) * SHM_K + KSWZ(ksr, ksc * 2)) = sr_[i].ks0; } \
    else { *(bf16x8*)(K_lds + (bb) * SHM_K + KSWZ(sr, kc)) = sr_[i].ks0;                       \
    *(bf16x8*)(K_lds + (bb) * SHM_K + KSWZ(32 + sr, kc)) = sr_[i].ks1; } } while (0)
#define SWAIT() do { if constexpr (ISB) asm volatile("s_waitcnt vmcnt(3)" ::: "memory"); else asm volatile("s_waitcnt vmcnt(4)" ::: "memory"); } while (0)
#define RESC(a) do { if (__any((a) < 1.f)) { if (hi == 0) al_l[r32] = (a); asm volatile("s_waitcnt lgkmcnt(0)" ::: "memory"); \
    _Pragma("unroll") for (int d = 0; d < 4; ++d) _Pragma("unroll") for (int r = 0; r < 16; ++r) o[d][r] *= al_l[crow(r, hi)]; } } while (0)
  f32x16 pA0, pA1, pB0, pB1; bf16x8 pa0, pa1, pa2, pa3;
  constexpr int SE = 0, SO = 1;
  SLOAD(SE, 0); asm volatile("s_waitcnt vmcnt(0)" ::: "memory"); SWRITE(0, SE); __syncthreads();
  qkt<ND0, ISB>(pA0, pA1, Kb, qr, r32, hi, kx, qx); partialSM<ISB>(pA0, pA1, mfix);
  SLOAD(SO, KVBLK); SLOAD(SE, 2 * KVBLK);
  SWAIT(); SWRITE(1, SO); __syncthreads();
  int sk = 1, sv = 0, sw = 2;
#define ROT() do { sv = sk; sk = sw; sw = (sw == 2) ? 0 : sw + 1; } while (0)
  for (int j = 1; j + 1 < NT; j += 2) {
    SBAR(); qkt<ND0, ISB>(pB0, pB1, Kb + sk * SHM_K, qr, r32, hi, kx, qx);
    finishSM<!ISB>(pA0, pA1, 1.f, l_reg, pa0, pa1, pa2, pa3); SBAR();
    SLOAD(SO, (j + 2) * KVBLK); SBAR();
    pv_d0(o, vb0 + sv * (int)SHM_V, pa0, pa1, pa2, pa3); RSUM(); partialSM<ISB>(pB0, pB1, mfix);
    SWAIT(); SWRITE(sw, SE);
    __syncthreads(); ROT();
    SBAR(); qkt<ND0, ISB>(pA0, pA1, Kb + sk * SHM_K, qr, r32, hi, kx, qx);
    finishSM<!ISB>(pB0, pB1, 1.f, l_reg, pa0, pa1, pa2, pa3); SBAR();
    if (j + 3 < NT) SLOAD(SE, (j + 3) * KVBLK); SBAR();
    pv_d0(o, vb0 + sv * (int)SHM_V, pa0, pa1, pa2, pa3); RSUM(); partialSM<ISB>(pA0, pA1, mfix);
    SWAIT(); SWRITE(sw, SO);
    __syncthreads(); ROT();
  }
  SBAR(); qkt<ND0, ISB>(pB0, pB1, Kb + sk * SHM_K, qr, r32, hi, kx, qx);
  finishSM<!ISB>(pA0, pA1, 1.f, l_reg, pa0, pa1, pa2, pa3); SBAR();
  pv_d0(o, vb0 + sv * (int)SHM_V, pa0, pa1, pa2, pa3); RSUM(); partialSM<ISB>(pB0, pB1, mfix);
  finishSM<!ISB>(pB0, pB1, 1.f, l_reg, pa0, pa1, pa2, pa3); SBAR();
  pv_d0(o, vb0 + sk * (int)SHM_V, pa0, pa1, pa2, pa3); RSUM();
#undef ROT
#undef RSUM
  float rli[16];
  if constexpr (ISB) {
#pragma unroll
    for (int r = 0; r < 16; ++r) rli[r] = __builtin_amdgcn_rcpf(o5[r]);
  } else {
    if (hi == 0) li_l[r32] = l_reg; asm volatile("s_waitcnt lgkmcnt(0)" ::: "memory");
#pragma unroll
    for (int r = 0; r < 16; ++r) rli[r] = __builtin_amdgcn_rcpf(li_l[crow(r, hi)]);
  }
  const size_t row0 = (size_t)(b * 4096 + qb * 256 + wid * QBLK);
  const int tmap = ISB ? ((vh - 4) & 1) : 0;
  if (ISB && tmap == 0) {
    bf16_t* Ow = O + row0 * LDO + vh * 128;
#pragma unroll
    for (int r = 0; r < 16; ++r) { const int orow = crow(r, hi);
#pragma unroll
      for (int d0 = 0; d0 < 4; ++d0) Ow[(size_t)orow * LDO + d0 * 32 + r32] = (bf16_t)(cvtpk(o[d0][r] * rli[r], 0.f) & 0xffffu); }
  } else {
    __syncthreads();
    bf16_t* tl = (bf16_t*)(lds + wid * 8192);
    const int lrow = lane >> 4, lc = (lane & 15) * 8;
    const bf16_t* te = tl + hi * 4 * 128 + r32;
#pragma unroll
    for (int r = 0; r < 16; ++r)
#pragma unroll
      for (int d0 = 0; d0 < 4; ++d0) o[d0][r] *= rli[r];
    const int gcol = ISB ? 512 + ((vh - 4) >> 1) * 128 : vh * 128;
    if constexpr (ISB) {
      { u32x4 v[8]; const bf16_t* src = O + (row0 + lrow) * LDO + (vh - 1) * 128 + lc;
#pragma unroll
        for (int i = 0; i < 8; ++i) v[i] = *(const u32x4*)(src + (size_t)(4 * i) * LDO);
#pragma unroll
        for (int i = 0; i < 8; ++i) *(u32x4*)(tl + (lrow + 4 * i) * 128 + lc) = v[i]; }
      asm volatile("s_waitcnt lgkmcnt(0)" ::: "memory");
#pragma unroll
      for (int r = 0; r < 16; ++r)
#pragma unroll
        for (int d0 = 0; d0 < 4; ++d0) o[d0][r] = bf2f((short)te[((r & 3) + 8 * (r >> 2)) * 128 + d0 * 32]) - lam * o[d0][r];
      asm volatile("s_waitcnt lgkmcnt(0)" ::: "memory");
    }
    { u32x4 v[8]; const bf16_t* src = P + (row0 + lrow) * LDQ + 1024 + gcol + lc;
#pragma unroll
      for (int i = 0; i < 8; ++i) v[i] = __builtin_nontemporal_load((const u32x4*)(src + (size_t)(4 * i) * LDQ));
#pragma unroll
      for (int i = 0; i < 8; ++i) *(u32x4*)(tl + (lrow + 4 * i) * 128 + lc) = v[i]; }
    asm volatile("s_waitcnt lgkmcnt(0)" ::: "memory");
    float sg[4];
#pragma unroll
    for (int d0 = 0; d0 < 4; ++d0) sg[d0] = ISB ? subln_g[d0 * 32 + r32] * 0.8f : 1.f;
    bf16_t* Gw = OG + row0 * 1024 + gcol + r32;
#pragma unroll
    for (int r = 0; r < 16; ++r) { const int orow = crow(r, hi); float rs = 1.f;
      if constexpr (ISB) { float ss = (o[0][r] * o[0][r] + o[1][r] * o[1][r]) + (o[2][r] * o[2][r] + o[3][r] * o[3][r]);
        ss += __shfl_xor(ss, 1); ss += __shfl_xor(ss, 2); ss += __shfl_xor(ss, 4); ss += __shfl_xor(ss, 8); ss += __shfl_xor(ss, 16);
        rs = rsqrtf(ss * (1.f / 128.f) + 1e-6f); }
#pragma unroll
      for (int d0 = 0; d0 < 4; ++d0) { const float g = bf2f((short)te[((r & 3) + 8 * (r >> 2)) * 128 + d0 * 32]);
        Gw[(size_t)orow * 1024 + d0 * 32] = (bf16_t)(cvtpk(o[d0][r] * rs * sg[d0] * (g / (1.f + __expf(-g))), 0.f) & 0xffffu); } }
  }
  asm volatile("s_waitcnt vmcnt(0)" ::: "memory");
  __syncthreads();
#undef SLOAD
#undef SWRITE
#undef SWAIT
#undef RESC
}

}

#define LAS __attribute__((address_space(3)))
typedef unsigned short bf16_t;
typedef float f32x4 __attribute__((ext_vector_type(4)));
typedef unsigned u32x4 __attribute__((ext_vector_type(4)));
typedef unsigned u32x2 __attribute__((ext_vector_type(2)));
constexpr int NWAVES = 8, LDS_BYTES = 147456;
constexpr int NLAT = 32768, NCTX = 2048, NROWS = NLAT + NCTX, DM = 1024, NPCOL = 3584, NQCOL = 2048;
constexpr size_t MiB = 1u << 20;
constexpr size_t WS_MODS = 0, WS_ROPEA = 256 * 1024, WS_ROPEB = 288 * 1024, WS_BAR = 512 * 1024, BAR_BYTES = 16384;
constexpr size_t WS_WIN = 1 * MiB, WS_WOUT = 9 * MiB, WS_WFO = 11 * MiB, WS_WFI = 13 * MiB, WS_DFT = 20 * MiB;
constexpr size_t WS_H = 84 * MiB;
constexpr size_t WS_P = 152 * MiB;
constexpr size_t WS_KV = 280 * MiB;
constexpr size_t WS_O = 390 * MiB;
constexpr size_t WS_X1 = WS_P, WS_HS = 280 * MiB  , WS_ZT = 408 * MiB  , WS_SG = WS_H, WS_T = WS_HS  , WS_FG = WS_HS + 64 * MiB, WS_END = 486 * MiB;
constexpr size_t WS_WUB = 37 * MiB, WS_CSM = 39 * MiB;
constexpr size_t WS_EXCH = 40 * MiB;
constexpr int KP = 2176;
static_assert(WS_ZT + (size_t)16384 * KP * 2 <= WS_END && WS_DFT + (size_t)4096 * KP * 2 <= WS_H && WS_O + 96 * MiB <= WS_END && WS_P + (size_t)NLAT * NQCOL * 2 <= WS_KV && WS_KV + (size_t)8 * 12 * 4352 * 128 * 2 <= WS_O && WS_H + (size_t)NROWS * DM * 2 <= WS_P, "ws map");

__device__ __forceinline__ float wave_sum(float v) {
#pragma unroll
    for (int o = 1; o < 64; o <<= 1) v += __shfl_xor(v, o);
    return v;
}
__device__ __forceinline__ unsigned pk2(float lo, float hi) { return pg8::cvt_pk_bf16(lo, hi); }
using pg8::bflo; using pg8::bfhi; using pg8::silu_f;

__device__ __forceinline__ void transpose_item(const float* W, int ldw, int nblk, int K, bf16_t* WT, int row_off, LAS float* scr, int item, int lane) {
    const int kb = item / nblk, nb = item % nblk, k0 = 64 * kb, n0 = 32 * nb;
    float wv[32];
#pragma unroll
    for (int i = 0; i < 32; ++i) wv[i] = W[(size_t)(k0 + 2 * i + (lane >> 5)) * ldw + n0 + (lane & 31)];
#pragma unroll
    for (int i = 0; i < 32; ++i) scr[(2 * i + (lane >> 5)) * 33 + (lane & 31)] = wv[i];
    asm volatile("s_waitcnt lgkmcnt(0)" ::: "memory");
    const int c = lane & 7;
#pragma unroll
    for (int j = 0; j < 4; ++j) { const int n = (lane >> 3) + 8 * j; const LAS float* s = scr + (8 * c) * 33 + n;
        u32x4 o; o.x = pk2(s[0 * 33], s[1 * 33]); o.y = pk2(s[2 * 33], s[3 * 33]); o.z = pk2(s[4 * 33], s[5 * 33]); o.w = pk2(s[6 * 33], s[7 * 33]);
        *(u32x4*)(WT + (size_t)(row_off + n0 + n) * K + k0 + 8 * c) = o; }
    asm volatile("s_waitcnt lgkmcnt(0)" ::: "memory");
}

#define RLX_AGENT __ATOMIC_RELAXED, __HIP_MEMORY_SCOPE_AGENT
#define XB_TMO      128
#define XB_XCNT(j)  (256  + 64 * (j))
#define XB_XSUB(j)  (1280 + 64 * (j))
#define XB_XGEN(j)  (2304 + 64 * (j))
#define XB_TOP      3328
#define XB_TOPGEN   3392
#define XCD_BAR_WORDS 3456
#define XB_SPIN_CAP (1u << 18)

__device__ __forceinline__ unsigned xb_ld(unsigned* p)              { return __hip_atomic_load(p, __ATOMIC_RELAXED, __HIP_MEMORY_SCOPE_AGENT); }
__device__ __forceinline__ unsigned xb_add(unsigned* p, unsigned v) { return __hip_atomic_fetch_add(p, v, __ATOMIC_RELAXED, __HIP_MEMORY_SCOPE_AGENT); }
__device__ __forceinline__ unsigned xb_xcc_id() { return (unsigned)__builtin_amdgcn_s_getreg((3 << 11) | 20) & 0xFu; }
#define XB_SPIN(cond, bar) do { unsigned _sp = 0; while (cond) { __builtin_amdgcn_s_sleep(1); \
    if ((++_sp & 255u) == 0u) { if (xb_ld(&(bar)[XB_TMO])) break; if (_sp > XB_SPIN_CAP) { atomicAdd(&(bar)[XB_TMO], 1u); break; } } } } while (0)

struct XcdBarrier {
    unsigned* bar; unsigned x;
    volatile LAS unsigned* st;
};

__device__ __forceinline__ XcdBarrier xcd_barrier_post(unsigned* bar, volatile LAS unsigned* st) {
    XcdBarrier b; b.bar = bar; b.x = xb_xcc_id(); b.st = st;
    if (threadIdx.x == 0) (void)xb_add(&bar[XB_XCNT(b.x)], 1u);
    return b;
}
__device__ __forceinline__ void xcd_barrier_complete(unsigned* bar, unsigned x, unsigned& nloc, unsigned& nx) {
    const unsigned G = gridDim.x * gridDim.y * gridDim.z;
    unsigned sum, cnt, mine, sp = 0u;
    for (;;) {
        sum = 0u; cnt = 0u; mine = 0u;
#pragma unroll
        for (unsigned j = 0; j < 16; ++j) { const unsigned c = xb_ld(&bar[XB_XCNT(j)]); sum += c; cnt += (c > 0u) ? 1u : 0u; mine = (j == x) ? c : mine; }
        if (sum == G) break;
        __builtin_amdgcn_s_sleep(1);
        if ((++sp & 255u) == 0u) { if (xb_ld(&bar[XB_TMO])) break; if (sp > XB_SPIN_CAP) { atomicAdd(&bar[XB_TMO], 1u); break; } }
    }
    nloc = mine > 0u ? mine : 1u; nx = cnt > 0u ? cnt : 1u;
}

__device__ __forceinline__ void xcd_barrier(const XcdBarrier& b) {
    asm volatile("s_waitcnt vmcnt(0)" ::: "memory");
    __syncthreads();
    if (threadIdx.x == 0) {
        unsigned* bar = b.bar;
        __builtin_amdgcn_s_waitcnt(0);
        unsigned nloc = b.st[0], nx = b.st[1];
        if (nloc == 0u) { xcd_barrier_complete(bar, b.x, nloc, nx); b.st[0] = nloc; b.st[1] = nx; }
        const unsigned old = xb_add(&bar[XB_XSUB(b.x)], 1u);
        const unsigned gen = old / nloc;
        if (old + 1u == (gen + 1u) * nloc) {
            __builtin_amdgcn_fence(__ATOMIC_RELEASE, "agent");
            asm volatile("s_waitcnt vmcnt(0)" ::: "memory");
            const unsigned og = xb_add(&bar[XB_TOP], 1u);
            const unsigned tg = og / nx;
            if (og + 1u == (tg + 1u) * nx) xb_add(&bar[XB_TOPGEN], 1u);
            else XB_SPIN(xb_ld(&bar[XB_TOPGEN]) == tg, bar);
            __builtin_amdgcn_fence(__ATOMIC_ACQUIRE, "agent");
            xb_add(&bar[XB_XGEN(b.x)], 1u);
            asm volatile("s_waitcnt vmcnt(0)" ::: "memory");
        } else {
            XB_SPIN(xb_ld(&bar[XB_XGEN(b.x)]) == gen, bar);
            __builtin_amdgcn_fence(__ATOMIC_ACQUIRE, "agent");
            asm volatile("s_waitcnt vmcnt(0)" ::: "memory");
        }
    }
    __syncthreads();
}


struct Args { const float* in[19]; float* out; unsigned char* ws; int ph_lo, ph_hi; };

__device__ __forceinline__ void p0_prep(const Args& a, unsigned char* lds, int tid, int lane, int wave, int bx, int G) {
    unsigned char* ws = a.ws;
    float* ldsf = (float*)lds;
    float* mods = (float*)(ws + WS_MODS);
    for (int s = bx; s < 192; s += G) {
        const int l = s / 96, j0 = (s % 96) * 32;
        float* sc = ldsf; float* red = ldsf + 9 * 1024;
        for (int i = tid; i < 9 * 1024; i += 512) { const int r = i >> 10, k = i & 1023; const float v = (r < 8) ? a.in[1][r * 1024 + k] : a.in[3][k]; sc[i] = silu_f(v); }
        __syncthreads();
        const int jj = tid & 31, kg = tid >> 5;
        const float* W = a.in[4] + (size_t)l * 1024 * 3072 + j0 + jj;
        float acc[9];
#pragma unroll
        for (int r = 0; r < 9; ++r) acc[r] = 0.f;
#pragma unroll 4
        for (int i = 0; i < 64; ++i) { const int k = kg + 16 * i; const float w = W[(size_t)k * 3072];
#pragma unroll
            for (int r = 0; r < 9; ++r) acc[r] += sc[r * 1024 + k] * w; }
#pragma unroll
        for (int r = 0; r < 9; ++r) red[(kg * 9 + r) * 32 + jj] = acc[r];
        __syncthreads();
        if (tid < 288) { const int r = tid >> 5, j = tid & 31; float s2 = 0.f;
#pragma unroll
            for (int q = 0; q < 16; ++q) s2 += red[(q * 9 + r) * 32 + j];
            mods[(l * 9 + r) * 3072 + j0 + j] = s2 + a.in[5][l * 3072 + j0 + j]; }
        __syncthreads();
    }
    {
        LAS float* scr = (LAS float*)((LAS unsigned char*)lds + wave * 16384);
        const int gw = bx * NWAVES + wave, NGW = G * NWAVES;
        constexpr int I_IN = 16 * 112, I_SQ = 16 * 32, NITEMS = I_IN + 3 * I_SQ;
        constexpr int EXTRA = 512;
        const int nfree = (G > 192) ? (G - 192) * NWAVES : 0;
        for (int pass = 0; pass < 2; ++pass)
        for (int it = (pass == 0) ? ((bx >= 192 && nfree >= EXTRA) ? (bx - 192) * NWAVES + wave : NITEMS) : ((nfree >= EXTRA ? EXTRA : 0) + gw); it < ((pass == 0) ? EXTRA : NITEMS); it += (pass == 0) ? nfree : NGW) {
            int r = it;
            if (r < I_IN) { transpose_item(a.in[7], 3584, 112, 1024, (bf16_t*)(ws + WS_WIN), 0, scr, r, lane); continue; } r -= I_IN;
            if (r < I_SQ) { transpose_item(a.in[15], 1024, 32, 1024, (bf16_t*)(ws + WS_WOUT), 0, scr, r, lane); continue; } r -= I_SQ;
            if (r < I_SQ) { transpose_item(a.in[17], 1024, 32, 1024, (bf16_t*)(ws + WS_WFO), 0, scr, r, lane); continue; } r -= I_SQ;
            transpose_item(a.in[16] + 1024, 2048, 32, 1024, (bf16_t*)(ws + WS_WFI), 2048, scr, r, lane);
        }
    }
    __syncthreads();
    {
        bf16_t* WuB = (bf16_t*)(ws + WS_WUB); bf16_t* CSm = (bf16_t*)(ws + WS_CSM);
        for (int v = bx * 512 + tid; v < 1024 * 128; v += G * 512) { const int k = v >> 7, c8 = (v & 127) * 8; const float* s = a.in[16] + (size_t)k * 2048 + c8;
            const f32x4 x0 = *(const f32x4*)s, x1 = *(const f32x4*)(s + 4);
            u32x4 o; o.x = pk2(x0[0], x0[1]); o.y = pk2(x0[2], x0[3]); o.z = pk2(x1[0], x1[1]); o.w = pk2(x1[2], x1[3]);
            *(u32x4*)(WuB + (size_t)k * 1024 + c8) = o; }
        for (int v = bx * 512 + tid; v < 2 * 256 * 32; v += G * 512) { const int cs = v >> 13, n = (v >> 5) & 255, c8 = (v & 31) * 8;
            float e[8];
#pragma unroll
            for (int i = 0; i < 8; ++i) { const float ph = (float)(((c8 + i) * n) & 255) * (1.f / 128.f); e[i] = (cs ? sinpif(ph) : cospif(ph)) * (1.f / 16.f); }
            u32x4 o; o.x = pk2(e[0], e[1]); o.y = pk2(e[2], e[3]); o.z = pk2(e[4], e[5]); o.w = pk2(e[6], e[7]);
            *(u32x4*)(CSm + (size_t)(cs * 1024 + n) * 256 + c8) = o; }
    }
    {
        float* tab = ldsf;
        for (int i = tid; i < 4096; i += 512) tab[i] = cospif((float)i * (1.f / 2048.f)) * (1.f / 64.f);
        __syncthreads();
        bf16_t* Dm = (bf16_t*)(ws + WS_DFT);
        const int total = 4096 * (KP / 8);
        for (int v = bx * 512 + tid; v < total; v += G * 512) {
            const int r = v / (KP / 8), n0 = (v % (KP / 8)) * 8, cs = r >> 11, np = r & 2047, lim = cs ? 2048 : 2049;
            float e[8];
#pragma unroll
            for (int i = 0; i < 8; ++i) e[i] = (n0 + i < lim) ? tab[((n0 + i) * np - 1024 * cs) & 4095] : 0.f;
            u32x4 o; o.x = pk2(e[0], e[1]); o.y = pk2(e[2], e[3]); o.z = pk2(e[4], e[5]); o.w = pk2(e[6], e[7]);
            *(u32x4*)(Dm + (size_t)r * KP + n0) = o;
        }
        __syncthreads();
    }
    if (bx == G - 1) {
        float2* rA = (float2*)(ws + WS_ROPEA); float2* rB = (float2*)(ws + WS_ROPEB);
        for (int i = tid; i < 64 * 32; i += 512) { const int pos = i >> 5, f = i & 31; const float inv = powf(10000.f, -(float)f / 32.f); const float ang = (float)pos * inv; rA[i] = make_float2(cosf(ang), sinf(ang)); }
        for (int i = tid; i < 64 * 16; i += 512) { const int pos = i >> 4, f = i & 15; const float inv = powf(10000.f, -(float)f / 16.f); const float ang = (float)pos * inv; rB[i] = make_float2(cosf(ang), sinf(ang)); }
    }
}

__device__ __forceinline__ void ld_row(const float* xrow, int lane, f32x4 (&v)[4]) {
    const f32x4* xr = (const f32x4*)xrow + lane;
#pragma unroll
    for (int j = 0; j < 4; ++j) v[j] = __builtin_nontemporal_load(xr + 64 * j);
}
__device__ __forceinline__ float row_rstd(const f32x4 (&v)[4]) {
    float s = 0.f;
#pragma unroll
    for (int j = 0; j < 4; ++j) s += (v[j].x * v[j].x + v[j].y * v[j].y) + (v[j].z * v[j].z + v[j].w * v[j].w);
    return rsqrtf(wave_sum(s) * (1.f / DM) + 1e-6f);
}
__device__ __forceinline__ void mod_fin(f32x4 (&y)[4], const float* g, const float* md, int lane) {
    const float rstd = row_rstd(y);
#pragma unroll
    for (int j = 0; j < 4; ++j) { const int col = 4 * (lane + 64 * j);
        const f32x4 gv = *(const f32x4*)(g + col), sh = *(const f32x4*)(md + col), sl = *(const f32x4*)(md + 1024 + col);
        y[j] = y[j] * rstd * gv * (sl + 1.f) + sh; }
}
__device__ __forceinline__ void st_row_bf16(bf16_t* dst, int lane, const f32x4 (&y)[4]) {
    unsigned long long* o8 = (unsigned long long*)dst + lane;
#pragma unroll
    for (int j = 0; j < 4; ++j) o8[64 * j] = (unsigned long long)pk2(y[j].x, y[j].y) | ((unsigned long long)pk2(y[j].z, y[j].w) << 32);
}
__device__ __forceinline__ void mod_params(const float* g, const float* md, int lane, f32x4 (&A)[4], f32x4 (&B)[4]) {
#pragma unroll
    for (int j = 0; j < 4; ++j) { const int col = 4 * (lane + 64 * j); A[j] = *(const f32x4*)(g + col) * (*(const f32x4*)(md + 1024 + col) + 1.f); B[j] = *(const f32x4*)(md + col); }
}
__device__ __forceinline__ void mod_apply(f32x4 (&y)[4], const f32x4 (&A)[4], const f32x4 (&B)[4]) {
    const float rstd = row_rstd(y);
#pragma unroll
    for (int j = 0; j < 4; ++j) y[j] = y[j] * rstd * A[j] + B[j];
}
__device__ __forceinline__ void modulate_rows(const float* X, int nlat, const float* Xc, int nctx, const float* g, const float* mods_l, bf16_t* H, int gw, int NGW, int lane) {
    for (int c = gw; c < nlat / 16; c += NGW) {
        const int r0 = c * 16; f32x4 A[4], B[4]; mod_params(g, mods_l + (r0 >> 12) * 3072, lane, A, B);
        f32x4 va[4][4], vb[4][4];
#define LD4(v, r) do { _Pragma("unroll") for (int i = 0; i < 4; ++i) ld_row(X + (size_t)((r) + i) * DM, lane, v[i]); } while (0)
#define FS4(v, r) do { _Pragma("unroll") for (int i = 0; i < 4; ++i) mod_apply(v[i], A, B); _Pragma("unroll") for (int i = 0; i < 4; ++i) st_row_bf16(H + (size_t)((r) + i) * DM, lane, v[i]); } while (0)
        LD4(va, r0); LD4(vb, r0 + 4); FS4(va, r0); LD4(va, r0 + 8); FS4(vb, r0 + 4); LD4(vb, r0 + 12); FS4(va, r0 + 8); FS4(vb, r0 + 12);
#undef LD4
#undef FS4
    }
    for (int m = gw; m < nctx; m += NGW) { f32x4 v[4]; ld_row(Xc + (size_t)m * DM, lane, v); mod_fin(v, g, mods_l + 8 * 3072, lane); st_row_bf16(H + (size_t)(nlat + m) * DM, lane, v); }
}

__device__ __forceinline__ void modulate_pairs(const float* X, const float* g, const float* mods_l, bf16_t* HS, const bf16_t* WfiT, bf16_t* Zt2, int bx, int wave, int gw, int NGW, int lane) {
    bf16_t* He = HS; bf16_t* Ho = HS + (size_t)16384 * DM; bf16_t* H1 = HS + (size_t)32768 * DM;
    for (int it = gw; it < 2048; it += NGW) {
        const int bq = it >> 8, ch0 = (it & 255) * 4;
        f32x4 y[4]; ld_row(X + (size_t)(bq * 4096 + 2048) * DM, lane, y); mod_fin(y, g, mods_l + bq * 3072, lane);
#pragma unroll
        for (int c = 0; c < 4; ++c) { const int ch = ch0 + c; const u32x2* wp = (const u32x2*)(WfiT + (size_t)ch * DM) + lane; float d = 0.f;
#pragma unroll
            for (int j = 0; j < 4; ++j) { const u32x2 w = wp[64 * j]; d += y[j].x * bflo(w.x) + y[j].y * bfhi(w.x) + y[j].z * bflo(w.y) + y[j].w * bfhi(w.y); }
            d = wave_sum(d);
            unsigned* z0 = (unsigned*)(Zt2 + ((size_t)((bq * 2 + 0) * 1024 + ch)) * KP + 2048) + lane;
            unsigned* z1 = (unsigned*)(Zt2 + ((size_t)((bq * 2 + 1) * 1024 + ch)) * KP + 2048) + lane;
            *z0 = (lane == 0) ? (pk2(d, 0.f) & 0xffffu) : 0u; *z1 = 0u; }
    }
    for (int it0 = gw; it0 < 8 * 2049; it0 += 2 * NGW) {
        f32x4 y[2][2][4]; int bb[2], nn[2];
#pragma unroll
        for (int i = 0; i < 2; ++i) { const int it = min(it0 + i * NGW, 8 * 2049 - 1); bb[i] = it / 2049; nn[i] = it % 2049;
            ld_row(X + (size_t)(bb[i] * 4096 + nn[i]) * DM, lane, y[i][0]); ld_row(X + (size_t)(bb[i] * 4096 + ((4096 - nn[i]) & 4095)) * DM, lane, y[i][1]); }
#pragma unroll
        for (int i = 0; i < 2; ++i) { const float* md = mods_l + bb[i] * 3072; mod_fin(y[i][0], g, md, lane); mod_fin(y[i][1], g, md, lane); }
#pragma unroll
        for (int i = 0; i < 2; ++i) { if (it0 + i * NGW >= 8 * 2049) break;
            const int b = bb[i], n = nn[i];
            st_row_bf16(H1 + (size_t)(b * 4096 + n) * DM, lane, y[i][0]);
            if (n == 0) { st_row_bf16(He + (size_t)(b * 2048) * DM, lane, y[i][0]);
                unsigned long long* o8 = (unsigned long long*)(Ho + (size_t)(b * 2048) * DM) + lane;
#pragma unroll
                for (int j = 0; j < 4; ++j) o8[64 * j] = 0ull; }
            else if (n < 2048) { st_row_bf16(H1 + (size_t)(b * 4096 + 4096 - n) * DM, lane, y[i][1]);
                f32x4 e[4], o[4];
#pragma unroll
                for (int j = 0; j < 4; ++j) { e[j] = y[i][0][j] + y[i][1][j]; o[j] = y[i][0][j] - y[i][1][j]; }
                st_row_bf16(He + (size_t)(b * 2048 + n) * DM, lane, e); st_row_bf16(Ho + (size_t)(b * 2048 + n) * DM, lane, o); }
        }
    }
}
__device__ __forceinline__ void nyquist_rows(const bf16_t* Zt2, const bf16_t* SG, bf16_t* FG, int gw, int NGW, int lane) {
    for (int it0 = gw; it0 < 8192; it0 += 4 * NGW) {
        u32x4 v[4][4]; unsigned short zl[4], sgv[4]; int itv[4];
#pragma unroll
        for (int i = 0; i < 4; ++i) { itv[i] = min(it0 + i * NGW, 8191); const int b = itv[i] >> 10, ch = itv[i] & 1023; const bf16_t* zp = Zt2 + ((size_t)((b * 2) * 1024 + ch)) * KP;
#pragma unroll
            for (int q = 0; q < 4; ++q) v[i][q] = *(const u32x4*)(zp + (q * 64 + lane) * 8);
            zl[i] = zp[2048]; sgv[i] = SG[(size_t)(b * 4096 + 2048) * DM + ch]; }
#pragma unroll
        for (int i = 0; i < 4; ++i) { if (it0 + i * NGW >= 8192) break;
            float s = 0.f;
#pragma unroll
            for (int q = 0; q < 4; ++q) { const u32x4 w = v[i][q]; s += (bflo(w.x) - bfhi(w.x)) + (bflo(w.y) - bfhi(w.y)) + (bflo(w.z) - bfhi(w.z)) + (bflo(w.w) - bfhi(w.w)); }
            s = wave_sum(s) + __uint_as_float(((unsigned)zl[i]) << 16);
            if (lane == 0) { const int b = itv[i] >> 10, ch = itv[i] & 1023; const size_t r = (size_t)(b * 4096 + 2048) * DM + ch;
                FG[r] = (bf16_t)(pk2(s * (1.f / 64.f) * __uint_as_float(((unsigned)sgv[i]) << 16), 0.f) & 0xffffu); } }
    }
}

__device__ __forceinline__ void kpost_rows(bf16_t* KV, const float* kn_g, const float2* ropeA, const float2* ropeB, unsigned* KM, int bx, int G, int wave, int lane, float* ldsf) {
    const int jA = (lane >> 4) & 1, iA = lane & 15, axA = iA >> 3, fbA = (iA & 7) * 4, dA = axA * 64 + fbA;
    const int subB = lane >> 3, iB = lane & 7, axB = iB >> 2, fbB = (iB & 3) * 4, dB = axB * 32 + fbB;
    float gA1[4], gA2[4];
#pragma unroll
    for (int e = 0; e < 4; ++e) { gA1[e] = kn_g[dA + e]; gA2[e] = kn_g[dA + 32 + e]; }
    for (int c = bx; c < 256; c += G) {
        const int b = c >> 5; float kmA = 0.f, kmB = 0.f;
        bf16_t* KA = KV + ((size_t)(b * 12 + jA) * 4352) * 128 + dA;
        bf16_t* KB = KV + ((size_t)(b * 12 + 4 + (subB >> 1)) * 4352) * 128 + (subB & 1) * 64 + dB;
        for (int i0 = 0; i0 < 17; i0 += 4) {
            u32x2 ra1[4], ra2[4], rb1[4], rb2[4]; int ki[4]; float2 csA[4][4], csB[4][4]; u32x2 wa1[4], wa2[4], wb1[4], wb2[4];
#pragma unroll
            for (int i = 0; i < 4; ++i) { ki[i] = (c & 31) * 136 + wave * 17 + min(i0 + i, 16);
                ra1[i] = *(const u32x2*)(KA + (size_t)ki[i] * 128); ra2[i] = *(const u32x2*)(KA + (size_t)ki[i] * 128 + 32);
                rb1[i] = *(const u32x2*)(KB + (size_t)ki[i] * 128); rb2[i] = *(const u32x2*)(KB + (size_t)ki[i] * 128 + 16);
                const int pos_ = (ki[i] - 256) & 4095, prow_ = pos_ >> 6, pcol_ = pos_ & 63;
#pragma unroll
                for (int e = 0; e < 4; ++e) { csA[i][e] = ropeA[(axA ? pcol_ : prow_) * 32 + fbA + e]; csB[i][e] = ropeB[(axB ? pcol_ : prow_) * 16 + fbB + e]; } }
#pragma unroll
            for (int i = 0; i < 4; ++i) { if (i0 + i >= 17) break;
                const int key = ki[i]; const bool lat = key >= 256; const int pos = (key - 256) & 4095, prow = pos >> 6, pcol = pos & 63;
                {
                    float x1[4] = {bflo(ra1[i].x), bfhi(ra1[i].x), bflo(ra1[i].y), bfhi(ra1[i].y)}, x2[4] = {bflo(ra2[i].x), bfhi(ra2[i].x), bflo(ra2[i].y), bfhi(ra2[i].y)};
                    float ss = 0.f;
#pragma unroll
                    for (int e = 0; e < 4; ++e) ss += x1[e] * x1[e] + x2[e] * x2[e];
                    ss += __shfl_xor(ss, 1); ss += __shfl_xor(ss, 2); ss += __shfl_xor(ss, 4); ss += __shfl_xor(ss, 8);
                    const float rstd = rsqrtf(ss * (1.f / 128.f) + 1e-6f);
                    const int pa = axA ? pcol : prow; float s2 = 0.f;
#pragma unroll
                    for (int e = 0; e < 4; ++e) { float a1 = x1[e] * rstd * gA1[e], a2 = x2[e] * rstd * gA2[e]; s2 += a1 * a1 + a2 * a2;
                        if (lat) { const float2 cs = csA[i][e]; const float t1 = a1 * cs.x - a2 * cs.y, t2 = a1 * cs.y + a2 * cs.x; a1 = t1; a2 = t2; }
                        x1[e] = a1; x2[e] = a2; }
                    s2 += __shfl_xor(s2, 1); s2 += __shfl_xor(s2, 2); s2 += __shfl_xor(s2, 4); s2 += __shfl_xor(s2, 8);
                    kmA = fmaxf(kmA, s2);
                    wa1[i].x = pk2(x1[0], x1[1]); wa1[i].y = pk2(x1[2], x1[3]); wa2[i].x = pk2(x2[0], x2[1]); wa2[i].y = pk2(x2[2], x2[3]);
                }
                {
                    float x1[4] = {bflo(rb1[i].x), bfhi(rb1[i].x), bflo(rb1[i].y), bfhi(rb1[i].y)}, x2[4] = {bflo(rb2[i].x), bfhi(rb2[i].x), bflo(rb2[i].y), bfhi(rb2[i].y)};
                    float s2 = 0.f;
#pragma unroll
                    for (int e = 0; e < 4; ++e) s2 += x1[e] * x1[e] + x2[e] * x2[e];
                    s2 += __shfl_xor(s2, 1); s2 += __shfl_xor(s2, 2); s2 += __shfl_xor(s2, 4);
                    kmB = fmaxf(kmB, s2);
                    if (lat) {
#pragma unroll
                        for (int e = 0; e < 4; ++e) { const float2 cs = csB[i][e]; const float t1 = x1[e] * cs.x - x2[e] * cs.y, t2 = x1[e] * cs.y + x2[e] * cs.x; x1[e] = t1; x2[e] = t2; }
                    }
                    wb1[i].x = pk2(x1[0], x1[1]); wb1[i].y = pk2(x1[2], x1[3]); wb2[i].x = pk2(x2[0], x2[1]); wb2[i].y = pk2(x2[2], x2[3]);
                }
            }
#pragma unroll
            for (int i = 0; i < 4; ++i) { if (i0 + i >= 17) break;
                const int key = ki[i];
                if (lane < 32) { *(u32x2*)(KA + (size_t)key * 128) = wa1[i]; *(u32x2*)(KA + (size_t)key * 128 + 32) = wa2[i]; }
                if (key >= 256) { *(u32x2*)(KB + (size_t)key * 128) = wb1[i]; *(u32x2*)(KB + (size_t)key * 128 + 16) = wb2[i]; } }
        }
        __syncthreads();
        if (lane == 0 || lane == 16) ldsf[wave * 10 + (lane >> 4)] = kmA;
        if ((lane & 7) == 0) ldsf[wave * 10 + 2 + subB] = kmB;
        __syncthreads();
        if (threadIdx.x < 10) { float v = 0.f;
#pragma unroll
            for (int w = 0; w < NWAVES; ++w) v = fmaxf(v, ldsf[w * 10 + threadIdx.x]);
            __hip_atomic_fetch_max(KM + b * 16 + threadIdx.x, __float_as_uint(v), __ATOMIC_RELAXED, __HIP_MEMORY_SCOPE_AGENT); }
    }
}

__device__ __forceinline__ void og_rows(const bf16_t* O, const bf16_t* P, const Args& a, bf16_t* OG, int gw, int NGW, int lane) {
    const float s1 = wave_sum(a.in[10][lane] * a.in[11][lane]), s2 = wave_sum(a.in[12][lane] * a.in[13][lane]);
    const float lam = expf(s1) - expf(s2) + 0.2f;
    const int h = lane >> 4, e0 = (lane & 15) * 8;
    float sg8[8];
#pragma unroll
    for (int e = 0; e < 8; ++e) sg8[e] = a.in[14][e0 + e] * 0.8f;
    for (int m0 = gw; m0 < NLAT; m0 += 2 * NGW) {
        u32x4 ovA[2], gvA[2], o1B[2], o2B[2], gvB[2]; int mi[2];
#pragma unroll
        for (int i = 0; i < 2; ++i) { mi[i] = min(m0 + i * NGW, NLAT - 1);
            const bf16_t* orow = O + (size_t)mi[i] * 1536; const bf16_t* grow = P + (size_t)mi[i] * NQCOL + 1024;
            ovA[i] = *(const u32x4*)(orow + 8 * lane); gvA[i] = *(const u32x4*)(grow + 8 * lane);
            o1B[i] = *(const u32x4*)(orow + 512 + (2 * h) * 128 + e0); o2B[i] = *(const u32x4*)(orow + 512 + (2 * h + 1) * 128 + e0); gvB[i] = *(const u32x4*)(grow + 512 + h * 128 + e0); }
#pragma unroll
        for (int i = 0; i < 2; ++i) { if (m0 + i * NGW >= NLAT) break;
            bf16_t* out = OG + (size_t)mi[i] * DM;
            {
                const u32x4 ov = ovA[i], gv = gvA[i];
                u32x4 w; w.x = pk2(bflo(ov.x) * silu_f(bflo(gv.x)), bfhi(ov.x) * silu_f(bfhi(gv.x))); w.y = pk2(bflo(ov.y) * silu_f(bflo(gv.y)), bfhi(ov.y) * silu_f(bfhi(gv.y)));
                w.z = pk2(bflo(ov.z) * silu_f(bflo(gv.z)), bfhi(ov.z) * silu_f(bfhi(gv.z))); w.w = pk2(bflo(ov.w) * silu_f(bflo(gv.w)), bfhi(ov.w) * silu_f(bfhi(gv.w)));
                *(u32x4*)(out + 8 * lane) = w;
            }
            {
                const u32x4 o1 = o1B[i], o2 = o2B[i], gv = gvB[i];
                float d[8] = {bflo(o1.x) - lam * bflo(o2.x), bfhi(o1.x) - lam * bfhi(o2.x), bflo(o1.y) - lam * bflo(o2.y), bfhi(o1.y) - lam * bfhi(o2.y),
                              bflo(o1.z) - lam * bflo(o2.z), bfhi(o1.z) - lam * bfhi(o2.z), bflo(o1.w) - lam * bflo(o2.w), bfhi(o1.w) - lam * bfhi(o2.w)};
                float gg[8] = {bflo(gv.x), bfhi(gv.x), bflo(gv.y), bfhi(gv.y), bflo(gv.z), bfhi(gv.z), bflo(gv.w), bfhi(gv.w)};
                float ss = 0.f;
#pragma unroll
                for (int e = 0; e < 8; ++e) ss += d[e] * d[e];
                ss += __shfl_xor(ss, 1); ss += __shfl_xor(ss, 2); ss += __shfl_xor(ss, 4); ss += __shfl_xor(ss, 8);
                const float rstd = rsqrtf(ss * (1.f / 128.f) + 1e-6f);
                float y[8];
#pragma unroll
                for (int e = 0; e < 8; ++e) y[e] = d[e] * rstd * sg8[e] * silu_f(gg[e]);
                u32x4 w; w.x = pk2(y[0], y[1]); w.y = pk2(y[2], y[3]); w.z = pk2(y[4], y[5]); w.w = pk2(y[6], y[7]);
                *(u32x4*)(out + 512 + h * 128 + e0) = w;
            }
        }
    }
}

__device__ __forceinline__ void final_norm_rows(float* out, const float* g, int gw, int NGW, int lane) {
    for (int m = gw; m < NLAT; m += 4 * NGW) {
        f32x4 v[4][4]; int mi[4];
#pragma unroll
        for (int i = 0; i < 4; ++i) { mi[i] = min(m + i * NGW, NLAT - 1); ld_row(out + (size_t)mi[i] * DM, lane, v[i]); }
#pragma unroll
        for (int i = 0; i < 4; ++i) { if (m + i * NGW >= NLAT) break;
            const float rstd = row_rstd(v[i]); f32x4* xr = (f32x4*)(out + (size_t)mi[i] * DM) + lane;
#pragma unroll
            for (int j = 0; j < 4; ++j) { const f32x4 gv = *(const f32x4*)(g + 4 * (lane + 64 * j)); xr[64 * j] = v[i][j] * rstd * gv; } }
    }
}

constexpr int N_PHASES = 12;
#ifndef MK_N_LAUNCHES
#define MK_N_LAUNCHES 1
#endif

__global__ void __launch_bounds__(NWAVES * 64, 2) mk_fwd(Args a) {
    extern __shared__ __attribute__((aligned(16))) unsigned char lds[];
    cg::grid_group grid = cg::this_grid();
    const int tid = threadIdx.x, lane = tid & 63, wave = __builtin_amdgcn_readfirstlane(tid >> 6);
    const int G = gridDim.x, bx = blockIdx.x, gw = bx * NWAVES + wave, NGW = G * NWAVES;
    unsigned char* ws = a.ws;
    const int lo = a.ph_lo, hi = a.ph_hi;
    float* mods = (float*)(ws + WS_MODS);
    const float2* ropeA = (const float2*)(ws + WS_ROPEA); const float2* ropeB = (const float2*)(ws + WS_ROPEB);
    bf16_t* H = (bf16_t*)(ws + WS_H); bf16_t* P = (bf16_t*)(ws + WS_P); bf16_t* O = (bf16_t*)(ws + WS_O); bf16_t* KVc = (bf16_t*)(ws + WS_KV);
    float* X1 = (float*)(ws + WS_X1); bf16_t* Zt = (bf16_t*)(ws + WS_ZT); bf16_t* SG = (bf16_t*)(ws + WS_SG);
    bf16_t* HS = (bf16_t*)(ws + WS_HS); bf16_t* FG = (bf16_t*)(ws + WS_FG); bf16_t* T = (bf16_t*)(ws + WS_T);
    PG8_LAS unsigned char* ldsl = (PG8_LAS unsigned char*)lds;
    volatile LAS unsigned* bst = (volatile LAS unsigned*)((LAS unsigned char*)lds + 131072 + 64);
    if (tid < 4) bst[tid] = 0u;
    __syncthreads();
    XcdBarrier bar; bar.bar = (unsigned*)(ws + WS_BAR); bar.x = 0; bar.st = bst;
    if (hi - lo > 1) {
        bar.x = xb_xcc_id();
        if (tid == 0) bst[2] = xb_add(&bar.bar[XB_XCNT(bar.x)], 1u);
    }
    int vcu = bx;
#define IN(k) (lo <= (k) && (k) < hi)
#define SEAM(k) do { if (IN(k) && IN((k) + 1)) xcd_barrier(bar); } while (0)
    if (lo > hi) grid.sync();
    typedef pg8::StaticOrder SO;

    if (IN(0)) p0_prep(a, lds, tid, lane, wave, bx, G);
    SEAM(0);
    if (IN(0) && IN(1) && G == 256) {
        if (tid == 0) { unsigned ok = (bar.x < 8u) ? 1u : 0u;
            for (unsigned j = 0; j < 16; ++j) { const unsigned c = xb_ld(&bar.bar[XB_XCNT(j)]); ok &= (c == (j < 8u ? 32u : 0u)) ? 1u : 0u; }
            bst[3] = ok; }
        __syncthreads();
        if (bst[3]) vcu = __builtin_amdgcn_readfirstlane((int)(bar.x + 8u * bst[2]));
    }
    if (IN(1)) {
        if (bx < 32) {
            const int g_ = bx >> 3, cs_ = (bx >> 2) & 1, pn_ = bx & 3;
            pg8::Gemm gm{(const bf16_t*)(ws + WS_CSM), (const bf16_t*)(ws + WS_WUB) + g_ * 256, 256, DM, 2048, DM, 256, -1, 0, 0, 0};
            pg8::OneUnit S1{cs_ * 4, pn_, 1};
            pg8::EpiPlain E1{(bf16_t*)(ws + WS_WFI) + (size_t)(g_ * 256) * DM, DM};
            pg8::gemm_phase<pg8::EpiPlain, pg8::OneUnit, true, true>(ldsl, gm, S1, E1);
        }
        modulate_rows(a.in[0], NLAT, a.in[2], NCTX, a.in[6], mods, H, gw, NGW, lane);
    }
    SEAM(1);
    if (IN(2)) {
        pg8::Gemm g{H, (const bf16_t*)(ws + WS_WIN), DM, DM, NROWS, NPCOL, DM, -1, 0, 0, 0}; SO S; S.init(NROWS, NPCOL, G, vcu);
        pg8::EpiInProj E{KVc, P};
        pg8::gemm_phase<pg8::EpiInProj, SO, true, true>(ldsl, g, S, E);
    }
    SEAM(2);
    unsigned* KM = (unsigned*)(ws + WS_BAR + 15360);
    if (IN(3)) kpost_rows(KVc, a.in[9], ropeA, ropeB, KM, bx, G, wave, lane, (float*)lds);
    SEAM(3);
    if (IN(4)) {
        const float s1 = wave_sum(a.in[10][lane] * a.in[11][lane]), s2 = wave_sum(a.in[12][lane] * a.in[13][lane]);
        const float lam = expf(s1) - expf(s2) + 0.2f;
        const int nA = (vcu < 512) ? (512 - vcu + G - 1) / G : 0;
        for (int k = 0; ; ++k) {
            const bool isA = k < nA; const int kb = k - nA;
            const int u = isA ? vcu + k * G : vcu + (kb >> 1) * G;
            if (!isA && u >= 512) break;
            const int round = u >> 8, w = u & 255, xcd = w & 7, slot = w >> 3, qb = slot & 15;
            if (isA) { const int pair = round * 8 + xcd, b = pair >> 1, kvh = pair & 1, vh = kvh * 2 + (slot >> 4);
                att::attn_unit<false>(P, KVc, O, H, lam, a.in[14], b, vh, qb, a.in[8], ropeA, ropeB, KM, (char*)lds); }
            else { const int t_ = kb & 1, head_ = (round * 8 + xcd) * 2 + (slot >> 4), b = head_ >> 2, h = head_ & 3, vh = 4 + 2 * h + t_;
                att::attn_unit<true>(P, KVc, O, H, lam, a.in[14], b, vh, qb, a.in[8], ropeA, ropeB, KM, (char*)lds); }
        }
    }
    SEAM(4);
    if (IN(6)) {
        pg8::Gemm g{H, (const bf16_t*)(ws + WS_WOUT), DM, DM, NLAT, DM, DM, -1, 0, 0, 0}; SO S; S.init(NLAT, DM, G, vcu);
        pg8::EpiResid E{a.in[0], X1, mods + 2048};
        pg8::gemm_phase<pg8::EpiResid, SO, true, true>(ldsl, g, S, E);
    }
    SEAM(6);
    if (IN(7)) modulate_pairs(X1, a.in[6] + DM, mods + 9 * 3072, HS, (const bf16_t*)(ws + WS_WFI), Zt, bx, wave, gw, NGW, lane);
    SEAM(7);
    if (IN(8)) {
        pg8::Gemm g{HS, (const bf16_t*)(ws + WS_WFI), DM, DM, 65536, DM, DM, -1, 6, 4, 2}; SO S; S.init(65536, DM, G, vcu);
        pg8::EpiFin E{Zt, SG};
        pg8::gemm_phase<pg8::EpiFin, SO, true, true>(ldsl, g, S, E);
    }
    SEAM(8);
    if (IN(9)) {
        nyquist_rows(Zt, SG, FG, gw, NGW, lane);
        pg8::Gemm g{(const bf16_t*)(ws + WS_DFT), Zt, KP, KP, 4096, 16384, KP, -1, 0, 0, 0}; pg8::PairOrder S{G, vcu};
        pg8::EpiDft E{SG, FG, T};
        pg8::gemm_phase<pg8::EpiDft, pg8::PairOrder, true, true>(ldsl, g, S, E);
    }
    SEAM(9);
    if (IN(10)) {
        pg8::Gemm g{FG, (const bf16_t*)(ws + WS_WFO), DM, DM, NLAT, DM, DM, -1, 0, 0, 0}; SO S; S.init(NLAT, DM, G, vcu);
        if (G == 256) {
            pg8::EpiFinal E{X1, a.out, mods + 9 * 3072 + 2048, a.in[18], (unsigned*)(ws + WS_EXCH), (unsigned*)(ws + WS_BAR + 15872), (PG8_LAS float*)(ldsl + 131072 + 1024)};
            pg8::gemm_phase<pg8::EpiFinal, SO, true, true>(ldsl, g, S, E);
        } else {
            pg8::EpiResid E{X1, a.out, mods + 9 * 3072 + 2048};
            pg8::gemm_phase<pg8::EpiResid, SO, true, true>(ldsl, g, S, E);
        }
    }
    if (G != 256) { SEAM(10); if (IN(11)) final_norm_rows(a.out, a.in[18], gw, NGW, lane); }
#undef IN
#undef SEAM
}

extern "C" void kernel_launch(void* const* d_in, const int* in_sizes, int n_in, void* d_out, int out_size, void* d_ws, size_t ws_size, hipStream_t stream) {
    static int grid = 0;
    if (grid == 0) {
        if (n_in != 19 || in_sizes[0] != NLAT * DM || out_size != NLAT * DM || ws_size < WS_END) {
            fprintf(stderr, "kernel_launch: unexpected shapes: n_in %d in0 %d out %d ws %zu (need >= %zu)\n", n_in, n_in > 0 ? in_sizes[0] : -1, out_size, ws_size, (size_t)WS_END); grid = -1; return; }
        int dev = 0, cus = 0, per_cu = 0;
        if (hipGetDevice(&dev) != hipSuccess || hipDeviceGetAttribute(&cus, hipDeviceAttributeMultiprocessorCount, dev) != hipSuccess) { grid = -1; return; }
        if (hipFuncSetAttribute((const void*)mk_fwd, hipFuncAttributeMaxDynamicSharedMemorySize, LDS_BYTES) != hipSuccess) { fprintf(stderr, "kernel_launch: hipFuncSetAttribute failed\n"); grid = -1; return; }
        if (hipOccupancyMaxActiveBlocksPerMultiprocessor(&per_cu, (const void*)mk_fwd, NWAVES * 64, LDS_BYTES) != hipSuccess || per_cu < 1) { fprintf(stderr, "kernel_launch: occupancy query gave %d\n", per_cu); per_cu = 1; }
        (void)hipGetLastError();
        grid = cus * 1;
    }
    if (grid < 0) return;
    Args a{};
    for (int i = 0; i < 19; ++i) a.in[i] = (const float*)d_in[i];
    a.out = (float*)d_out; a.ws = (unsigned char*)d_ws;
#if MK_N_LAUNCHES == 1
    if (hipMemsetAsync((unsigned char*)d_ws + WS_BAR, 0, BAR_BYTES, stream) != hipSuccess) { fprintf(stderr, "kernel_launch: memset failed\n"); return; }
    a.ph_lo = 0; a.ph_hi = N_PHASES;
    void* args[] = {&a};
    hipError_t e = hipLaunchCooperativeKernel((const void*)mk_fwd, dim3(grid), dim3(NWAVES * 64), args, LDS_BYTES, stream);
    if (e != hipSuccess) fprintf(stderr, "kernel_launch: cooperative launch failed: %s (grid %d)\n", hipGetErrorString(e), grid);
#else
    for (int p = 0; p < N_PHASES; ++p) {
        a.ph_lo = p; a.ph_hi = p + 1;
        hipLaunchKernelGGL(mk_fwd, dim3(grid), dim3(NWAVES * 64), LDS_BYTES, stream, a);
    }
    const hipError_t le = hipPeekAtLastError();
    if (le != hipSuccess) fprintf(stderr, "kernel_launch: launch failed: %s\n", hipGetErrorName(le));
#endif
}
```

```cpp
#include <hip/hip_runtime.h>
#include <hip/hip_cooperative_groups.h>
#include <cstdio>
#include <cstdint>
namespace cg = cooperative_groups;
namespace pg8 {
#define PG8_LAS __attribute__((address_space(3)))
typedef unsigned short bf16_t;
typedef short bf16x8 __attribute__((ext_vector_type(8)));
typedef float f32x4 __attribute__((ext_vector_type(4)));
typedef unsigned u32x4 __attribute__((ext_vector_type(4)));
constexpr int BM = 256, BK = 64, HALF = 128, HTB = HALF * BK * 2  , STAGE_BYTES = 8 * HTB, NXCD = 8, WGM = 8;

__host__ __device__ __forceinline__ int lds_byte(int r, int c) { const int st = (r >> 4) * 2 + (c >> 5), rr = r & 15, cc = c & 31, ob = rr * 64 + cc * 2; return st * 1024 + (ob ^ (((ob >> 9) & 1) << 5)); }
__host__ __device__ __forceinline__ void stage_rc(int b, int& R, int& C) { const int st = b / 1024, sb = b % 1024, swz = sb ^ (((sb >> 9) & 1) << 5); R = (st >> 1) * 16 + swz / 64; C = (st & 1) * 32 + (swz % 64) / 2; }
__host__ __device__ __forceinline__ int perm32(int rho) { const int n = rho >> 4, i = rho & 15; return 8 * (i >> 2) + 4 * n + (i & 3); }

struct Unit { int pm, pn; };
struct Gemm { const bf16_t* A; const bf16_t* Bt; int lda, ldb; int M, N, K; int amask, bshift, bmul, bcap; };

struct StaticOrder {
    int nM, nN, nwg, G, c;
    __host__ __device__ void init(int M, int N, int G_, int c_) { nM = M / BM; nN = N / BM; nwg = nM * nN; G = G_; c = c_; }
    __host__ __device__ bool next(int i, Unit& u) const {
        const long L = (long)i * G + c; if (L >= nwg) return false;
        int wgid = (int)L; { const int q = nwg / NXCD, r = nwg % NXCD, xcd = wgid % NXCD, off = wgid / NXCD; wgid = (xcd < r ? xcd * (q + 1) : r * (q + 1) + (xcd - r) * q) + off; }
        const int nig = WGM * nN, gid = wgid / nig, fm = gid * WGM, gsz = (nM - fm) < WGM ? (nM - fm) : WGM;
        u.pm = fm + ((wgid % nig) % gsz); u.pn = (wgid % nig) / gsz; return true;
    }
    __device__ __forceinline__ void a_ready(const Unit&) const {}
    __device__ __forceinline__ void done(const Unit&) const {}
};

struct OneUnit {
    int pm, pn, valid;
    __host__ __device__ bool next(int i, Unit& u) const { if (i != 0 || !valid) return false; u.pm = pm; u.pn = pn; return true; }
    __device__ __forceinline__ void a_ready(const Unit&) const {}
    __device__ __forceinline__ void done(const Unit&) const {}
};

struct PairOrder {
    int G, c;
    __host__ __device__ bool next(int i, Unit& u) const {
        const int L = (i >> 1) * G + c; if (L >= 256) return false;
        const int which = i & 1, nblk = (L >> 3) & 7, q = (L & 7) + 8 * (L >> 6), b = q >> 2, pn = q & 3;
        u.pm = which * 8 + nblk; u.pn = (b * 2 + which) * 4 + pn; return true;
    }
    __device__ __forceinline__ void a_ready(const Unit&) const {}
    __device__ __forceinline__ void done(const Unit&) const {}
};

__device__ __forceinline__ unsigned cvt_pk_bf16(float lo, float hi) { unsigned r; asm volatile("v_cvt_pk_bf16_f32 %0, %1, %2" : "=v"(r) : "v"(lo), "v"(hi)); return r; }
__device__ __forceinline__ float bflo(unsigned w) { return __uint_as_float(w << 16); }
__device__ __forceinline__ float bfhi(unsigned w) { return __uint_as_float(w & 0xffff0000u); }
__device__ __forceinline__ float silu_f(float x) { return x / (1.f + __expf(-x)); }

struct EpiPlain {
    static constexpr bool PERM = true, AFTER_DRAIN = false;
    bf16_t* O; int ldc;
    __device__ __forceinline__ void operator()(const f32x4 (&acc)[2][2][4][2], const Unit& u, int wr, int wc, int fr, int fq) const {
        const int row0 = u.pm * BM + wr * 64 + fr, col0 = u.pn * BM + wc * 32 + 8 * fq;
#pragma unroll
        for (int ai = 0; ai < 2; ++ai)
#pragma unroll
            for (int m = 0; m < 4; ++m) { bf16_t* rowp = O + (size_t)(row0 + ai * HALF + m * 16) * ldc + col0;
#pragma unroll
                for (int bj = 0; bj < 2; ++bj) { const f32x4 v0 = acc[ai][bj][m][0], v1 = acc[ai][bj][m][1];
                    u32x4 w; w.x = cvt_pk_bf16(v0[0], v0[1]); w.y = cvt_pk_bf16(v0[2], v0[3]); w.z = cvt_pk_bf16(v1[0], v1[1]); w.w = cvt_pk_bf16(v1[2], v1[3]);
                    *(u32x4*)(rowp + bj * HALF) = w; } }
    }
};

struct EpiInProj {
    static constexpr bool PERM = true, AFTER_DRAIN = false;
    bf16_t* KV; bf16_t* PQ;
    __device__ __forceinline__ void operator()(const f32x4 (&acc)[2][2][4][2], const Unit& u, int wr, int wc, int fr, int fq) const {
        const int rit = wr * 64 + fr, cit = wc * 32 + 8 * fq;
        if (u.pn < 6) {
            const int b = u.pm < 128 ? (u.pm >> 4) : (u.pm - 128), key0 = u.pm < 128 ? 256 + (u.pm & 15) * BM : 0;
#pragma unroll
            for (int bj = 0; bj < 2; ++bj) { bf16_t* base = KV + ((size_t)(b * 12 + 2 * u.pn + bj) * 4352 + key0 + rit) * 128 + cit;
#pragma unroll
                for (int ai = 0; ai < 2; ++ai)
#pragma unroll
                    for (int m = 0; m < 4; ++m) { const f32x4 v0 = acc[ai][bj][m][0], v1 = acc[ai][bj][m][1];
                        u32x4 w; w.x = cvt_pk_bf16(v0[0], v0[1]); w.y = cvt_pk_bf16(v0[2], v0[3]); w.z = cvt_pk_bf16(v1[0], v1[1]); w.w = cvt_pk_bf16(v1[2], v1[3]);
                        *(u32x4*)(base + (size_t)(ai * HALF + m * 16) * 128) = w; } }
        } else if (u.pm < 128) {
            bf16_t* base = PQ + (size_t)(u.pm * BM + rit) * 2048 + (u.pn - 6) * BM + cit;
#pragma unroll
            for (int ai = 0; ai < 2; ++ai)
#pragma unroll
                for (int m = 0; m < 4; ++m) { bf16_t* rowp = base + (size_t)(ai * HALF + m * 16) * 2048;
#pragma unroll
                    for (int bj = 0; bj < 2; ++bj) { const f32x4 v0 = acc[ai][bj][m][0], v1 = acc[ai][bj][m][1];
                        u32x4 w; w.x = cvt_pk_bf16(v0[0], v0[1]); w.y = cvt_pk_bf16(v0[2], v0[3]); w.z = cvt_pk_bf16(v1[0], v1[1]); w.w = cvt_pk_bf16(v1[2], v1[3]);
                        *(u32x4*)(rowp + bj * HALF) = w; } }
        }
    }
};

struct EpiResid {
    static constexpr bool PERM = true, AFTER_DRAIN = false;
    const float* resid; float* out; const float* gate;
    __device__ __forceinline__ void operator()(const f32x4 (&acc)[2][2][4][2], const Unit& u, int wr, int wc, int fr, int fq) const {
        const int row0 = u.pm * BM + wr * 64 + fr, col0 = u.pn * BM + wc * 32 + 8 * fq;
        const float* gp = gate + (size_t)((u.pm * BM) >> 12) * 3072 + col0;
        f32x4 gv[2][2];
#pragma unroll
        for (int bj = 0; bj < 2; ++bj)
#pragma unroll
            for (int n = 0; n < 2; ++n) gv[bj][n] = *(const f32x4*)(gp + bj * HALF + 4 * n);
#pragma unroll
        for (int ai = 0; ai < 2; ++ai)
#pragma unroll
            for (int m = 0; m < 4; m += 2) {
                const float* __restrict__ rp = resid; float* __restrict__ op = out; f32x4 r[2][2][2];
#pragma unroll
                for (int mm = 0; mm < 2; ++mm) { const size_t ro = (size_t)(row0 + ai * HALF + (m + mm) * 16) * 1024 + col0;
#pragma unroll
                    for (int bj = 0; bj < 2; ++bj)
#pragma unroll
                        for (int n = 0; n < 2; ++n) r[mm][bj][n] = __builtin_nontemporal_load((const f32x4*)(rp + ro + bj * HALF + 4 * n)); }
#pragma unroll
                for (int mm = 0; mm < 2; ++mm) { const size_t ro = (size_t)(row0 + ai * HALF + (m + mm) * 16) * 1024 + col0;
#pragma unroll
                    for (int bj = 0; bj < 2; ++bj)
#pragma unroll
                        for (int n = 0; n < 2; ++n) *(f32x4*)(op + ro + bj * HALF + 4 * n) = r[mm][bj][n] + gv[bj][n] * acc[ai][bj][m + mm][n]; } }
    }
};


struct EpiFinal {
    static constexpr bool PERM = true, AFTER_DRAIN = false;
    const float* resid; float* out; const float* gate; const float* fg; unsigned* exch; unsigned* cnt; PG8_LAS float* lsc;
    __device__ __forceinline__ void operator()(const f32x4 (&acc_)[2][2][4][2], const Unit& u, int wr, int wc, int fr, int fq) const {
        f32x4 (&acc)[2][2][4][2] = const_cast<f32x4 (&)[2][2][4][2]>(acc_);
        const int tid = threadIdx.x;
        const int row0 = u.pm * BM + wr * 64 + fr, col0 = u.pn * BM + wc * 32 + 8 * fq;
        const float* gp = gate + (size_t)((u.pm * BM) >> 12) * 3072 + col0;
        f32x4 gv[2][2];
#pragma unroll
        for (int bj = 0; bj < 2; ++bj)
#pragma unroll
            for (int n = 0; n < 2; ++n) gv[bj][n] = *(const f32x4*)(gp + bj * HALF + 4 * n);
#pragma unroll
        for (int ai = 0; ai < 2; ++ai)
#pragma unroll
            for (int m = 0; m < 4; ++m) { const size_t ro = (size_t)(row0 + ai * HALF + m * 16) * 1024 + col0; float s = 0.f;
#pragma unroll
                for (int bj = 0; bj < 2; ++bj)
#pragma unroll
                    for (int n = 0; n < 2; ++n) { const f32x4 r = __builtin_nontemporal_load((const f32x4*)(resid + ro + bj * HALF + 4 * n)); const f32x4 v = r + gv[bj][n] * acc[ai][bj][m][n];
                        acc[ai][bj][m][n] = v; s += (v[0] * v[0] + v[1] * v[1]) + (v[2] * v[2] + v[3] * v[3]); }
                s += __shfl_xor(s, 16); s += __shfl_xor(s, 32);
                if (fq == 0) lsc[wc * 256 + ai * HALF + wr * 64 + m * 16 + fr] = s; }
        asm volatile("s_waitcnt lgkmcnt(0)" ::: "memory"); __builtin_amdgcn_s_barrier();
        if (tid < 256) { const float t = (lsc[tid] + lsc[256 + tid]) + (lsc[512 + tid] + lsc[768 + tid]);
            __hip_atomic_store(exch + (size_t)(u.pm * 4 + u.pn) * 256 + tid, __float_as_uint(t), __ATOMIC_RELAXED, __HIP_MEMORY_SCOPE_AGENT); }
        asm volatile("s_waitcnt vmcnt(0) lgkmcnt(0)" ::: "memory"); __builtin_amdgcn_s_barrier();
        if (tid == 0) { __builtin_amdgcn_fence(__ATOMIC_RELEASE, "agent");
            __hip_atomic_fetch_add(cnt + u.pm, 1u, __ATOMIC_RELAXED, __HIP_MEMORY_SCOPE_AGENT);
            unsigned sp = 0; while (__hip_atomic_load(cnt + u.pm, __ATOMIC_RELAXED, __HIP_MEMORY_SCOPE_AGENT) < 4u && ++sp < (1u << 22)) __builtin_amdgcn_s_sleep(1);
            __builtin_amdgcn_fence(__ATOMIC_ACQUIRE, "agent"); asm volatile("s_waitcnt vmcnt(0)" ::: "memory"); }
        __builtin_amdgcn_s_barrier();
        if (tid < 256) { float tot = 0.f;
#pragma unroll
            for (int j = 0; j < 4; ++j) tot += __uint_as_float(__hip_atomic_load(exch + (size_t)(u.pm * 4 + j) * 256 + tid, __ATOMIC_RELAXED, __HIP_MEMORY_SCOPE_AGENT));
            lsc[1024 + tid] = rsqrtf(tot * (1.f / 1024.f) + 1e-6f); }
        asm volatile("s_waitcnt vmcnt(0) lgkmcnt(0)" ::: "memory"); __builtin_amdgcn_s_barrier();
        f32x4 fv[2][2];
#pragma unroll
        for (int bj = 0; bj < 2; ++bj)
#pragma unroll
            for (int n = 0; n < 2; ++n) fv[bj][n] = *(const f32x4*)(fg + col0 + bj * HALF + 4 * n);
#pragma unroll
        for (int ai = 0; ai < 2; ++ai)
#pragma unroll
            for (int m = 0; m < 4; ++m) { const size_t ro = (size_t)(row0 + ai * HALF + m * 16) * 1024 + col0; const float rs = lsc[1024 + ai * HALF + wr * 64 + m * 16 + fr];
#pragma unroll
                for (int bj = 0; bj < 2; ++bj)
#pragma unroll
                    for (int n = 0; n < 2; ++n) *(f32x4*)(out + ro + bj * HALF + 4 * n) = acc[ai][bj][m][n] * rs * fv[bj][n]; }
        asm volatile("s_waitcnt lgkmcnt(0)" ::: "memory"); __builtin_amdgcn_s_barrier();
    }
};

struct EpiFin {
    static constexpr bool PERM = true, AFTER_DRAIN = false;
    bf16_t* Zt; bf16_t* SG;
    __device__ __forceinline__ void operator()(const f32x4 (&acc)[2][2][4][2], const Unit& u, int wr, int wc, int fr, int fq) const {
        const int col0 = u.pn * BM + wc * 32 + 8 * fq;
        if (u.pm < 128) {
            const int which = u.pm >> 6, b = (u.pm & 63) >> 3, n0 = (u.pm & 7) * BM + wr * 64 + fr;
#pragma unroll
            for (int bj = 0; bj < 2; ++bj)
#pragma unroll
                for (int n = 0; n < 2; ++n)
#pragma unroll
                    for (int i = 0; i < 4; ++i) { const int ch = col0 + bj * HALF + 4 * n + i;
                        bf16_t* zp = Zt + ((size_t)((b * 2 + which) * 1024 + ch)) * 2176 + n0;
#pragma unroll
                        for (int ai = 0; ai < 2; ++ai)
#pragma unroll
                            for (int m = 0; m < 4; ++m) zp[ai * HALF + m * 16] = (bf16_t)(cvt_pk_bf16(acc[ai][bj][m][n][i], 0.f) & 0xffffu); }
        } else {
            const int row0 = (u.pm - 128) * BM + wr * 64 + fr;
#pragma unroll
            for (int ai = 0; ai < 2; ++ai)
#pragma unroll
                for (int m = 0; m < 4; ++m) { bf16_t* rowp = SG + (size_t)(row0 + ai * HALF + m * 16) * 1024 + col0;
#pragma unroll
                    for (int bj = 0; bj < 2; ++bj) { const f32x4 v0 = acc[ai][bj][m][0], v1 = acc[ai][bj][m][1];
                        u32x4 w; w.x = cvt_pk_bf16(silu_f(v0[0]), silu_f(v0[1])); w.y = cvt_pk_bf16(silu_f(v0[2]), silu_f(v0[3]));
                        w.z = cvt_pk_bf16(silu_f(v1[0]), silu_f(v1[1])); w.w = cvt_pk_bf16(silu_f(v1[2]), silu_f(v1[3]));
                        *(u32x4*)(rowp + bj * HALF) = w; } }
        }
    }
};

struct EpiDft {
    static constexpr bool PERM = true, AFTER_DRAIN = false;
    const bf16_t* SG; bf16_t* FG; bf16_t* T;
    __device__ __forceinline__ void operator()(const f32x4 (&acc)[2][2][4][2], const Unit& u, int wr, int wc, int fr, int fq) const {
        const int which = u.pm >> 3, b = u.pn >> 3, np0 = (u.pm & 7) * BM + wr * 64 + fr, col0 = (u.pn & 3) * BM + wc * 32 + 8 * fq;
        if (which == 0) {
#pragma unroll
            for (int ai = 0; ai < 2; ++ai)
#pragma unroll
                for (int m = 0; m < 4; ++m) { bf16_t* tp = T + (size_t)(b * 2048 + np0 + ai * HALF + m * 16) * 1024 + col0;
#pragma unroll
                    for (int bj = 0; bj < 2; ++bj) { const f32x4 v0 = acc[ai][bj][m][0], v1 = acc[ai][bj][m][1];
                        u32x4 w; w.x = cvt_pk_bf16(v0[0], v0[1]); w.y = cvt_pk_bf16(v0[2], v0[3]); w.z = cvt_pk_bf16(v1[0], v1[1]); w.w = cvt_pk_bf16(v1[2], v1[3]);
                        *(u32x4*)(tp + bj * HALF) = w; } }
        } else {
#pragma unroll
            for (int ai = 0; ai < 2; ++ai)
#pragma unroll
                for (int m = 0; m < 4; ++m) { const int np = np0 + ai * HALF + m * 16; const bf16_t* __restrict__ tp = T + (size_t)(b * 2048 + np) * 1024 + col0;
                    const size_t r1 = (size_t)(b * 4096 + np) * 1024 + col0, r2 = (size_t)(b * 4096 + 4096 - np) * 1024 + col0;
                    const bf16_t* __restrict__ SGr = SG; bf16_t* __restrict__ FGw = FG;
                    u32x4 twv[2], sv[2], tv[2];
#pragma unroll
                    for (int bj = 0; bj < 2; ++bj) { twv[bj] = *(const u32x4*)(tp + bj * HALF); sv[bj] = *(const u32x4*)(SGr + r1 + bj * HALF); tv[bj] = *(const u32x4*)(SGr + (np != 0 ? r2 : r1) + bj * HALF); }
#pragma unroll
                    for (int bj = 0; bj < 2; ++bj) { const u32x4 tw = twv[bj];
                        const f32x4 a0 = {bflo(tw.x), bfhi(tw.x), bflo(tw.y), bfhi(tw.y)}, a1 = {bflo(tw.z), bfhi(tw.z), bflo(tw.w), bfhi(tw.w)};
                        const f32x4 v0 = a0 - acc[ai][bj][m][0], v1 = a1 - acc[ai][bj][m][1];
                        const u32x4 s = sv[bj];
                        u32x4 w; w.x = cvt_pk_bf16(v0[0] * bflo(s.x), v0[1] * bfhi(s.x)); w.y = cvt_pk_bf16(v0[2] * bflo(s.y), v0[3] * bfhi(s.y));
                        w.z = cvt_pk_bf16(v1[0] * bflo(s.z), v1[1] * bfhi(s.z)); w.w = cvt_pk_bf16(v1[2] * bflo(s.w), v1[3] * bfhi(s.w));
                        *(u32x4*)(FGw + r1 + bj * HALF) = w;
                        if (np != 0) { const f32x4 y0 = a0 + acc[ai][bj][m][0], y1 = a1 + acc[ai][bj][m][1];
                            const u32x4 t = tv[bj];
                            u32x4 x; x.x = cvt_pk_bf16(y0[0] * bflo(t.x), y0[1] * bfhi(t.x)); x.y = cvt_pk_bf16(y0[2] * bflo(t.y), y0[3] * bfhi(t.y));
                            x.z = cvt_pk_bf16(y1[0] * bflo(t.z), y1[1] * bfhi(t.z)); x.w = cvt_pk_bf16(y1[2] * bflo(t.w), y1[3] * bfhi(t.w));
                            *(u32x4*)(FGw + r2 + bj * HALF) = x; } } }
        }
    }
};

template <class Epi, class Sched, bool ALIGN_EPI = false, bool SP2 = false>
__device__ __forceinline__ void gemm_phase(PG8_LAS unsigned char* lds, const Gemm g, const Sched& S, const Epi& E) {
    const int tid = threadIdx.x, wid = __builtin_amdgcn_readfirstlane(tid >> 6), lane = tid & 63, wr = wid >> 2, wc = wid & 3, fr = lane & 15, fq = lane >> 4;
    const int K = g.K, nt = K / BK;
    unsigned voffA[2], voffB[2];
#pragma unroll
    for (int i = 0; i < 2; ++i) { int R, C; stage_rc(tid * 16 + i * 8192, R, C); const int Rb = Epi::PERM ? ((R & ~31) + perm32(R & 31)) : R;
        voffA[i] = (unsigned)(R * g.lda + C) * 2u; voffB[i] = (unsigned)(Rb * g.ldb + C) * 2u; }
    const size_t kstep = (size_t)(BK * 2);
    const size_t hstepA = (size_t)HALF * g.lda * 2, hstepB = (size_t)HALF * g.ldb * 2;
    const size_t tstepA = 2 * hstepA, tstepB = 2 * hstepB;
    const unsigned ldsw = (unsigned)wid * 1024u;
    const int aoff = lds_byte(wr * 64 + fr, fq * 8), boff = lds_byte(wc * 32 + fr, fq * 8);
#define PG8_SA(b, h) (((b) * 2 + (h)) * HTB)
#define PG8_SB(b, h) ((4 + (b) * 2 + (h)) * HTB)
#define PG8_STAGE(bufoff, gbase, voff) do { _Pragma("unroll") for (int _i = 0; _i < 2; ++_i) \
        __builtin_amdgcn_global_load_lds((const unsigned*)((const char*)(gbase) + (voff)[_i]), (PG8_LAS unsigned*)(lds + (bufoff) + ldsw + _i * 8192), 16, 0, 0); } while (0)
#define PG8_LDA(dst, b, h) do { _Pragma("unroll") for (int m = 0; m < 4; ++m) _Pragma("unroll") for (int k = 0; k < 2; ++k) dst[m][k] = *(const PG8_LAS bf16x8*)(lds + PG8_SA(b, h) + aoff + m * 2048 + k * 1024); } while (0)
#define PG8_LDB(dst, b, h) do { _Pragma("unroll") for (int n = 0; n < 2; ++n) _Pragma("unroll") for (int k = 0; k < 2; ++k) dst[n][k] = *(const PG8_LAS bf16x8*)(lds + PG8_SB(b, h) + boff + n * 2048 + k * 1024); } while (0)
#define PG8_MMA(ai, bj, At, Bt) do { __builtin_amdgcn_s_setprio(1); _Pragma("unroll") for (int m = 0; m < 4; ++m) _Pragma("unroll") for (int n = 0; n < 2; ++n) _Pragma("unroll") for (int k = 0; k < 2; ++k) \
        acc[ai][bj][m][n] = __builtin_amdgcn_mfma_f32_16x16x32_bf16(Bt[n][k], At[m][k], acc[ai][bj][m][n], 0, 0, 0); __builtin_amdgcn_s_setprio(0); } while (0)
#define PG8_WAIT_V(n) asm volatile("s_waitcnt vmcnt(" #n ")" ::: "memory")
#define PG8_WAIT_L(n) asm volatile("s_waitcnt lgkmcnt(" #n ")" ::: "memory")
#define PG8_BAR __builtin_amdgcn_s_barrier()
#define PG8_SCHED __builtin_amdgcn_sched_barrier(0)
    Unit cur, nxt; int ui = 0;
    if (!S.next(0, cur)) return;
    f32x4 acc[2][2][4][2];
#pragma unroll
    for (int a = 0; a < 2; ++a)
#pragma unroll
        for (int b = 0; b < 2; ++b)
#pragma unroll
            for (int m = 0; m < 4; ++m)
#pragma unroll
                for (int n = 0; n < 2; ++n) acc[a][b][m][n] = (f32x4){0.f, 0.f, 0.f, 0.f};
    bf16x8 At[4][2], B0[2][2], B1[2][2];
    const char* cA = (const char*)g.A + (size_t)(cur.pm & g.amask) * tstepA; const char* cB = (const char*)g.Bt + (size_t)(cur.pn + min(cur.pm >> g.bshift, g.bcap) * g.bmul) * tstepB;
    S.a_ready(cur);
    if constexpr (SP2) {
        PG8_STAGE(PG8_SB(0, 0), cB, voffB); PG8_STAGE(PG8_SB(0, 1), cB + hstepB, voffB); PG8_STAGE(PG8_SA(0, 0), cA, voffA); PG8_STAGE(PG8_SA(0, 1), cA + hstepA, voffA);
        if (wr == 1) PG8_BAR;
        PG8_WAIT_V(2); PG8_BAR;
        PG8_STAGE(PG8_SB(1, 0), cB + kstep, voffB); PG8_STAGE(PG8_SA(1, 0), cA + kstep, voffA); PG8_STAGE(PG8_SB(1, 1), cB + hstepB + kstep, voffB);
        PG8_WAIT_V(6); PG8_BAR;
    } else {
        PG8_STAGE(PG8_SB(0, 0), cB, voffB); PG8_STAGE(PG8_SA(0, 0), cA, voffA); PG8_STAGE(PG8_SB(0, 1), cB + hstepB, voffB); PG8_STAGE(PG8_SA(0, 1), cA + hstepA, voffA);
        if (wr == 1) PG8_BAR;
        PG8_WAIT_V(4); PG8_BAR;
        PG8_STAGE(PG8_SB(1, 0), cB + kstep, voffB); PG8_STAGE(PG8_SA(1, 0), cA + kstep, voffA); PG8_STAGE(PG8_SB(1, 1), cB + hstepB + kstep, voffB);
        PG8_WAIT_V(6); PG8_BAR;
    }
    for (;;) {
        const bool has_next = S.next(ui + 1, nxt);
        const char* nA = has_next ? (const char*)g.A + (size_t)(nxt.pm & g.amask) * tstepA : cA; const char* nB = has_next ? (const char*)g.Bt + (size_t)(nxt.pn + min(nxt.pm >> g.bshift, g.bcap) * g.bmul) * tstepB : cB;
        for (int t = 0; t < nt; t += 2) {
            const bool last = (t == nt - 2);
            const char* a1 = cA + (size_t)(t + 1) * kstep;
            const char* a2 = last ? nA : cA + (size_t)(t + 2) * kstep; const char* b2 = last ? nB : cB + (size_t)(t + 2) * kstep;
            const char* a3 = a2 + kstep; const char* b3 = b2 + kstep;
            if (last && has_next) S.a_ready(nxt);
            if constexpr (SP2) {
            PG8_LDB(B0, 0, 0); PG8_LDB(B1, 0, 1); PG8_SCHED; PG8_LDA(At, 0, 0); PG8_STAGE(PG8_SA(1, 1), a1 + hstepA, voffA);
            PG8_WAIT_V(8); PG8_WAIT_L(0); PG8_BAR; PG8_MMA(0, 0, At, B0); PG8_MMA(0, 1, At, B1); PG8_BAR; PG8_SCHED;
            PG8_LDA(At, 0, 1); PG8_STAGE(PG8_SB(0, 0), b2, voffB); PG8_STAGE(PG8_SB(0, 1), b2 + hstepB, voffB); PG8_STAGE(PG8_SA(0, 0), a2, voffA);
            PG8_WAIT_V(8); PG8_WAIT_L(0); PG8_BAR; PG8_MMA(1, 0, At, B0); PG8_MMA(1, 1, At, B1); PG8_BAR; PG8_SCHED;
            PG8_LDB(B0, 1, 0); PG8_LDB(B1, 1, 1); PG8_SCHED; PG8_LDA(At, 1, 0); PG8_STAGE(PG8_SA(0, 1), a2 + hstepA, voffA);
            PG8_WAIT_V(8); PG8_WAIT_L(0); PG8_BAR; PG8_MMA(0, 0, At, B0); PG8_MMA(0, 1, At, B1); PG8_BAR; PG8_SCHED;
            PG8_LDA(At, 1, 1); PG8_STAGE(PG8_SB(1, 0), b3, voffB); PG8_STAGE(PG8_SB(1, 1), b3 + hstepB, voffB); PG8_STAGE(PG8_SA(1, 0), a3, voffA);
            PG8_WAIT_V(8); PG8_WAIT_L(0); PG8_BAR; PG8_MMA(1, 0, At, B0); PG8_MMA(1, 1, At, B1); PG8_BAR; PG8_SCHED;
            } else {
            PG8_LDB(B0, 0, 0); PG8_SCHED; PG8_LDA(At, 0, 0); PG8_STAGE(PG8_SA(1, 1), a1 + hstepA, voffA);
            PG8_WAIT_L(8); PG8_BAR; PG8_WAIT_L(0); PG8_MMA(0, 0, At, B0); PG8_BAR; PG8_SCHED;
            PG8_LDB(B1, 0, 1); PG8_STAGE(PG8_SB(0, 0), b2, voffB);
            PG8_BAR; PG8_WAIT_L(0); PG8_MMA(0, 1, At, B1); PG8_BAR;
            PG8_LDA(At, 0, 1); PG8_STAGE(PG8_SA(0, 0), a2, voffA);
            PG8_BAR; PG8_WAIT_L(0); PG8_MMA(1, 0, At, B0); PG8_BAR; PG8_SCHED;
            PG8_STAGE(PG8_SB(0, 1), b2 + hstepB, voffB);
            PG8_WAIT_V(6); PG8_BAR; PG8_MMA(1, 1, At, B1); PG8_BAR;
            PG8_LDB(B0, 1, 0); PG8_SCHED; PG8_LDA(At, 1, 0); PG8_STAGE(PG8_SA(0, 1), a2 + hstepA, voffA);
            PG8_WAIT_L(8); PG8_BAR; PG8_WAIT_L(0); PG8_MMA(0, 0, At, B0); PG8_BAR; PG8_SCHED;
            PG8_LDB(B1, 1, 1); PG8_STAGE(PG8_SB(1, 0), b3, voffB);
            PG8_BAR; PG8_WAIT_L(0); PG8_MMA(0, 1, At, B1); PG8_BAR;
            PG8_LDA(At, 1, 1); PG8_STAGE(PG8_SA(1, 0), a3, voffA);
            PG8_BAR; PG8_WAIT_L(0); PG8_MMA(1, 0, At, B0); PG8_BAR; PG8_SCHED;
            PG8_STAGE(PG8_SB(1, 1), b3 + hstepB, voffB);
            PG8_WAIT_V(6); PG8_BAR; PG8_MMA(1, 1, At, B1); PG8_BAR;
            }
        }
        if constexpr (ALIGN_EPI) { if (wr == 0) PG8_BAR; }
        if constexpr (!Epi::AFTER_DRAIN) { E(acc, cur, wr, wc, fr, fq); S.done(cur); }
        if (!has_next) break;
#pragma unroll
        for (int a = 0; a < 2; ++a)
#pragma unroll
            for (int b = 0; b < 2; ++b)
#pragma unroll
                for (int m = 0; m < 4; ++m)
#pragma unroll
                    for (int n = 0; n < 2; ++n) acc[a][b][m][n] = (f32x4){0.f, 0.f, 0.f, 0.f};
        cur = nxt; cA = nA; cB = nB; ++ui;
        if constexpr (ALIGN_EPI) { if (wr == 1) PG8_BAR; }
    }
    PG8_WAIT_V(0);
    if constexpr (!ALIGN_EPI) { if (wr == 0) PG8_BAR; }
    PG8_BAR;
    if constexpr (Epi::AFTER_DRAIN) { E.fused(acc, cur, wr, wc, fr, fq, lds, wid, lane); S.done(cur); }
#undef PG8_SA
#undef PG8_SB
#undef PG8_STAGE
#undef PG8_LDA
#undef PG8_LDB
#undef PG8_MMA
#undef PG8_WAIT_V
#undef PG8_WAIT_L
#undef PG8_BAR
#undef PG8_SCHED
}
}

namespace att {
typedef unsigned short bf16_t;
using bf16x8 = __attribute__((ext_vector_type(8))) short;
using s16x4  = __attribute__((ext_vector_type(4))) short;
using f32x16 = __attribute__((ext_vector_type(16))) float;
using u32x4  = __attribute__((ext_vector_type(4))) unsigned;
constexpr int   D = 128, NW = 8, QBLK = 32, KVBLK = 64;
constexpr float SCALE = 0.088388347648318440f;
constexpr float THR = 8.f;
constexpr int LDQ = 2048, LDK = 128, LDO = 1536, NKEY = 4352, NT = NKEY / KVBLK;
constexpr size_t SHM_V = KVBLK * D * 2, SHM_K = KVBLK * D * 2, SHM_ATTN = 3 * SHM_V + 3 * SHM_K + NW * 64 * 4;
#define KSWZ(row, colB) ((row) * 256 + ((colB) ^ (((row) & 7) << 4)))
#define SBAR() __builtin_amdgcn_sched_barrier(0)
__device__ __forceinline__ int crow(int r, int hi) { return (r & 3) + 8 * (r >> 2) + 4 * hi; }
__device__ __forceinline__ unsigned cvtpk(float lo, float hi) { unsigned r; asm volatile("v_cvt_pk_bf16_f32 %0, %1, %2" : "=v"(r) : "v"(lo), "v"(hi)); return r; }
__device__ __forceinline__ bf16x8 ld8(const bf16_t* p) { return *reinterpret_cast<const bf16x8*>(p); }

template <bool EXT>
__device__ __forceinline__ void partialSM(f32x16& p0, f32x16& p1, const float mfix) {
  if constexpr (!EXT) {
    constexpr float C = SCALE * 1.4426950408889634f; const float mnC = -mfix * C;
#pragma unroll
    for (int r = 0; r < 16; ++r) p0[r] = fmaf(p0[r], C, mnC);
#pragma unroll
    for (int r = 0; r < 16; ++r) p1[r] = fmaf(p1[r], C, mnC);
  }
#pragma unroll
  for (int r = 0; r < 16; ++r) p0[r] = __builtin_amdgcn_exp2f(p0[r]);
}
template <bool VSUM>
__device__ __forceinline__ void finishSM(f32x16& p0, f32x16& p1, float alpha, float& l_reg, bf16x8& pa0, bf16x8& pa1, bf16x8& pa2, bf16x8& pa3) {
#pragma unroll
  for (int r = 0; r < 16; ++r) p1[r] = __builtin_amdgcn_exp2f(p1[r]);
  if constexpr (VSUM) {
  float ps = 0;
#pragma unroll
  for (int r = 0; r < 16; ++r) ps += p0[r];
#pragma unroll
  for (int r = 0; r < 16; ++r) ps += p1[r];
  { auto rr = __builtin_amdgcn_permlane32_swap(__float_as_uint(ps), __float_as_uint(ps), false, false);
    ps = __uint_as_float(rr[0]) + __uint_as_float(rr[1]); }
  l_reg = l_reg * alpha + ps;
  }
#define PK4(P, BASE, OUT) do { unsigned a0 = cvtpk(P[BASE + 0], P[BASE + 1]), a1 = cvtpk(P[BASE + 2], P[BASE + 3]);   \
    unsigned b0 = cvtpk(P[BASE + 4], P[BASE + 5]), b1 = cvtpk(P[BASE + 6], P[BASE + 7]);                              \
    auto r0 = __builtin_amdgcn_permlane32_swap(a0, b0, false, false); auto r1 = __builtin_amdgcn_permlane32_swap(a1, b1, false, false); \
    u32x4 w = {r0[0], r1[0], r0[1], r1[1]}; OUT = *reinterpret_cast<bf16x8*>(&w); } while (0)
  PK4(p0, 0, pa0); PK4(p0, 8, pa1); PK4(p1, 0, pa2); PK4(p1, 8, pa3);
#undef PK4
}
template <int ND0, bool EXT>
__device__ __forceinline__ void qkt(f32x16& p0, f32x16& p1, const char* Ks, const bf16x8* qr, int r32, int hi, const bf16x8 kx, const bf16x8 qx) {
  if constexpr (EXT) { p0 = __builtin_amdgcn_mfma_f32_32x32x16_bf16(kx, qx, f32x16{}, 0, 0, 0);
    p1 = __builtin_amdgcn_mfma_f32_32x32x16_bf16(kx, qx, f32x16{}, 0, 0, 0); }
  else { p0 = f32x16{}; p1 = f32x16{}; }
#pragma unroll
  for (int d0 = 0; d0 < ND0; ++d0) { int cb = (d0 * 16 + hi * 8) * 2;
    bf16x8 b0 = *reinterpret_cast<const bf16x8*>(Ks + KSWZ(r32, cb));
    bf16x8 b1 = *reinterpret_cast<const bf16x8*>(Ks + KSWZ(32 + r32, cb));
    p0 = __builtin_amdgcn_mfma_f32_32x32x16_bf16(b0, qr[d0], p0, 0, 0, 0);
    p1 = __builtin_amdgcn_mfma_f32_32x32x16_bf16(b1, qr[d0], p1, 0, 0, 0); }
}
__device__ __forceinline__ int v_st(int k, int c) { const int kk = (k & ~0xC) | ((k & 4) << 1) | ((k & 8) >> 1); return ((kk >> 3) * 4 + (c >> 5)) * 512 + ((kk & 7) * 32 + (c & 31)) * 2; }
__device__ __forceinline__ int v_rd_base(int lane) { return ((lane & 3) << 3) | (((lane >> 2) & 3) << 6) | (((lane >> 4) & 1) << 5) | (((lane >> 5) & 1) << 8); }
constexpr int v_rd_off(int d0, int ks, int half) { return d0 * 512 + ks * 4096 + half * 2048; }
template <int OFF> __device__ __forceinline__ s16x4 tr_read(int vb) {
  s16x4 r; asm volatile("ds_read_b64_tr_b16 %0, %1 offset:%2" : "=&v"(r) : "v"(vb), "i"(OFF) : "memory"); return r;
}
template <int KS> __device__ __forceinline__ void pv_ks(f32x16* o, int vb, bf16x8 pa) {
  const s16x4 l0 = tr_read<v_rd_off(0, KS, 0)>(vb), h0 = tr_read<v_rd_off(0, KS, 1)>(vb), l1 = tr_read<v_rd_off(1, KS, 0)>(vb), h1 = tr_read<v_rd_off(1, KS, 1)>(vb);
  const s16x4 l2 = tr_read<v_rd_off(2, KS, 0)>(vb), h2 = tr_read<v_rd_off(2, KS, 1)>(vb), l3 = tr_read<v_rd_off(3, KS, 0)>(vb), h3 = tr_read<v_rd_off(3, KS, 1)>(vb);
  asm volatile("s_waitcnt lgkmcnt(0)" ::: "memory"); SBAR();
#define PK(L, H) (bf16x8){L[0], L[1], L[2], L[3], H[0], H[1], H[2], H[3]}
  o[0] = __builtin_amdgcn_mfma_f32_32x32x16_bf16(pa, PK(l0, h0), o[0], 0, 0, 0);
  o[1] = __builtin_amdgcn_mfma_f32_32x32x16_bf16(pa, PK(l1, h1), o[1], 0, 0, 0);
  o[2] = __builtin_amdgcn_mfma_f32_32x32x16_bf16(pa, PK(l2, h2), o[2], 0, 0, 0);
  o[3] = __builtin_amdgcn_mfma_f32_32x32x16_bf16(pa, PK(l3, h3), o[3], 0, 0, 0);
#undef PK
}
__device__ __forceinline__ void pv_d0(f32x16* o, int vb, bf16x8 pa0, bf16x8 pa1, bf16x8 pa2, bf16x8 pa3) {
  pv_ks<0>(o, vb, pa0); pv_ks<1>(o, vb, pa1); pv_ks<2>(o, vb, pa2); pv_ks<3>(o, vb, pa3);
}
__device__ __forceinline__ float bf2f(short h) { return __uint_as_float(((unsigned)(unsigned short)h) << 16); }

template <bool ISB>
__device__ __forceinline__ void attn_unit(const bf16_t* __restrict__ P, const bf16_t* __restrict__ KV, bf16_t* __restrict__ O, bf16_t* __restrict__ OG, const float lam, const float* __restrict__ subln_g, int b, int vh, int qb,
                                          const float* __restrict__ qn_g, const float2* __restrict__ ropeA, const float2* __restrict__ ropeB, const unsigned* KM, char* lds) {
  constexpr int ND0 = ISB ? 4 : 8;
  int tid_ = threadIdx.x; asm volatile("" : "+v"(tid_));
  const int tid = tid_, wid = tid >> 6, lane = tid & 63, r32 = lane & 31, hi = lane >> 5;
  char* V_lds = lds; char* K_lds = lds + 3 * SHM_V;
  float* ws = (float*)(lds + 3 * SHM_V + 3 * SHM_K) + wid * 64; float* li_l = ws; float* al_l = ws + 32;
  int qcol, kcol, vcol, koffB = 0;
  int kslot, vslot;
  if constexpr (ISB) { const int h = (vh - 4) >> 1, t = (vh - 4) & 1; qcol = 512 + h * 128 + t * 64; kslot = 4 + h; vslot = 8 + h; koffB = t * 128; }
  else { const int kvh = vh >> 1; qcol = vh * 128; kslot = kvh; vslot = 2 + kvh; }
  kcol = 0; vcol = 0;
  const bf16_t* Kc = KV + (size_t)(b * 12 + kslot) * 4352 * 128; const bf16_t* Vc = KV + (size_t)(b * 12 + vslot) * 4352 * 128;
  const float kmax2 = __uint_as_float(KM[b * 16 + (ISB ? 2 + (vh - 4) : (vh >> 1))]);
  float l_reg = 0; f32x16 o[4] = {}; bf16x8 qr[ND0]; float mfix; bool usefix;
  {
    const int pos = qb * 256 + wid * QBLK + r32, prow = pos >> 6, pcol = pos & 63;
    const bf16_t* Qw = P + (size_t)(b * 4096 + pos) * LDQ + qcol + hi * 8;
    float qf[ND0][8];
#pragma unroll
    for (int d0 = 0; d0 < ND0; ++d0) { const bf16x8 raw = ld8(Qw + d0 * 16);
#pragma unroll
      for (int i = 0; i < 8; ++i) qf[d0][i] = bf2f(raw[i]); }
    if constexpr (!ISB) {
      float ss = 0.f;
#pragma unroll
      for (int d0 = 0; d0 < 8; ++d0)
#pragma unroll
        for (int i = 0; i < 8; ++i) ss += qf[d0][i] * qf[d0][i];
      { auto rr = __builtin_amdgcn_permlane32_swap(__float_as_uint(ss), __float_as_uint(ss), false, false);
        ss = __uint_as_float(rr[0]) + __uint_as_float(rr[1]); }
      const float rstd = rsqrtf(ss * (1.f / 128.f) + 1e-6f);
#pragma unroll
      for (int d0 = 0; d0 < 8; ++d0)
#pragma unroll
        for (int i = 0; i < 8; ++i) qf[d0][i] *= rstd * qn_g[d0 * 16 + hi * 8 + i];
#pragma unroll
      for (int ax = 0; ax < 2; ++ax) { const int pa = ax ? pcol : prow;
#pragma unroll
        for (int e = 0; e < 2; ++e) { const int dl = ax * 4 + e, dh = dl + 2;
#pragma unroll
          for (int i = 0; i < 8; ++i) { const float2 cs = ropeA[pa * 32 + e * 16 + hi * 8 + i]; const float x1 = qf[dl][i], x2 = qf[dh][i];
            qf[dl][i] = x1 * cs.x - x2 * cs.y; qf[dh][i] = x1 * cs.y + x2 * cs.x; } } }
    } else {
#pragma unroll
      for (int ax = 0; ax < 2; ++ax) { const int pa = ax ? pcol : prow; const int dl = ax * 2, dh = dl + 1;
#pragma unroll
        for (int i = 0; i < 8; ++i) { const float2 cs = ropeB[pa * 16 + hi * 8 + i]; const float x1 = qf[dl][i] * 1.41421356237f, x2 = qf[dh][i] * 1.41421356237f;
          qf[dl][i] = x1 * cs.x - x2 * cs.y; qf[dh][i] = x1 * cs.y + x2 * cs.x; } }
    }
    constexpr float CQ = ISB ? SCALE * 1.4426950408889634f : 1.f;
#pragma unroll
    for (int d0 = 0; d0 < ND0; ++d0) { u32x4 w = {cvtpk(qf[d0][0] * CQ, qf[d0][1] * CQ), cvtpk(qf[d0][2] * CQ, qf[d0][3] * CQ), cvtpk(qf[d0][4] * CQ, qf[d0][5] * CQ), cvtpk(qf[d0][6] * CQ, qf[d0][7] * CQ)};
      qr[d0] = *reinterpret_cast<bf16x8*>(&w); }
    float nq2 = 0.f;
#pragma unroll
    for (int d0 = 0; d0 < ND0; ++d0)
#pragma unroll
      for (int i = 0; i < 8; ++i) nq2 += qf[d0][i] * qf[d0][i];
    { auto rr = __builtin_amdgcn_permlane32_swap(__float_as_uint(nq2), __float_as_uint(nq2), false, false);
      nq2 = __uint_as_float(rr[0]) + __uint_as_float(rr[1]); }
    mfix = sqrtf(nq2 * kmax2) * 1.02f + 0.1f;
    usefix = __all(mfix * SCALE <= 40.f);
    mfix *= CQ;
  }
  if (!usefix) {
    float mx = -3.0e38f;
    for (int j = 0; j < NT; ++j) {
      const bf16_t* rb_ = Kc + (size_t)(j * KVBLK) * LDK + (koffB >> 1) + hi * 8;
      f32x16 s0 = {}, s1 = {};
#pragma unroll
      for (int d0 = 0; d0 < ND0; ++d0) { const bf16x8 b0 = ld8(rb_ + (size_t)r32 * LDK + d0 * 16), b1 = ld8(rb_ + (size_t)(32 + r32) * LDK + d0 * 16);
        s0 = __builtin_amdgcn_mfma_f32_32x32x16_bf16(b0, qr[d0], s0, 0, 0, 0); s1 = __builtin_amdgcn_mfma_f32_32x32x16_bf16(b1, qr[d0], s1, 0, 0, 0); }
#pragma unroll
      for (int r = 0; r < 16; ++r) mx = fmaxf(mx, fmaxf(s0[r], s1[r]));
    }
    { auto rr = __builtin_amdgcn_permlane32_swap(__float_as_uint(mx), __float_as_uint(mx), false, false); mx = fmaxf(__uint_as_float(rr[0]), __uint_as_float(rr[1])); }
    mfix = mx;
  }
  bf16x8 kx, qx, ones; f32x16 o5 = {};
  { u32x4 w = {hi == 0 ? 0x3F80u : 0u, 0u, 0u, 0u}; kx = *reinterpret_cast<bf16x8*>(&w); u32x4 w2 = {hi == 0 ? (cvtpk(-mfix, 0.f) & 0xffffu) : 0u, 0u, 0u, 0u}; qx = *reinterpret_cast<bf16x8*>(&w2);
    u32x4 w1 = {0x3F803F80u, 0x3F803F80u, 0x3F803F80u, 0x3F803F80u}; ones = *reinterpret_cast<bf16x8*>(&w1); }
#define RSUM() do { if constexpr (ISB) { o5 = __builtin_amdgcn_mfma_f32_32x32x16_bf16(pa0, ones, o5, 0, 0, 0); o5 = __builtin_amdgcn_mfma_f32_32x32x16_bf16(pa1, ones, o5, 0, 0, 0); \
    o5 = __builtin_amdgcn_mfma_f32_32x32x16_bf16(pa2, ones, o5, 0, 0, 0); o5 = __builtin_amdgcn_mfma_f32_32x32x16_bf16(pa3, ones, o5, 0, 0, 0); } } while (0)
  const int sr = tid >> 4, sc = (tid & 15) * 8, vst0 = v_st(sr, sc), vst1 = v_st(32 + sr, sc);
  const int vb0 = (int)(uintptr_t)V_lds + v_rd_base(lane);
  const char* Kb = K_lds + koffB;
  struct { bf16x8 vs0, vs1, ks0, ks1; } sr_[2];
  const int ksr = tid >> 3, ksc = (tid & 7) * 8 + (koffB >> 1);
#define SLOAD(i, k0) do { const bf16_t* vb_ = Vc + (size_t)(k0) * LDK; const bf16_t* kb_ = Kc + (size_t)(k0) * LDK; sr_[i].vs0 = ld8(vb_ + (size_t)sr * LDK + sc); sr_[i].vs1 = ld8(vb_ + (size_t)(32 + sr) * LDK + sc); \
    if constexpr (ISB) { sr_[i].ks0 = ld8(kb_ + (size_t)ksr * LDK + ksc); } \
    else { sr_[i].ks0 = ld8(kb_ + (size_t)sr * LDK + sc); sr_[i].ks1 = ld8(kb_ + (size_t)(32 + sr) * LDK + sc); } } while (0)
#define SWRITE(bb, i) do { *(bf16x8*)(V_lds + (bb) * SHM_V + vst0) = sr_[i].vs0;          \
    *(bf16x8*)(V_lds + (bb) * SHM_V + vst1) = sr_[i].vs1; int kc = sc * 2;               \
    if constexpr (ISB) { *(bf16x8*)(K_lds + (bb) * SHM_K + KSWZ(ksr, ksc * 2)) = sr_[i].ks0; } \
    else { *(bf16x8*)(K_lds + (bb) * SHM_K + KSWZ(sr, kc)) = sr_[i].ks0;                       \
    *(bf16x8*)(K_lds + (bb) * SHM_K + KSWZ(32 + sr, kc)) = sr_[i].ks1; } } while (0)
#define SWAIT() do { if constexpr (ISB) asm volatile("s_waitcnt vmcnt(3)" ::: "memory"); else asm volatile("s_waitcnt vmcnt(4)" ::: "memory"); } while (0)
#define RESC(a) do { if (__any((a) < 1.f)) { if (hi == 0) al_l[r32] = (a); asm volatile("s_waitcnt lgkmcnt(0)" ::: "memory"); \
    _Pragma("unroll") for (int d = 0; d < 4; ++d) _Pragma("unroll") for (int r = 0; r < 16; ++r) o[d][r] *= al_l[crow(r, hi)]; } } while (0)
  f32x16 pA0, pA1, pB0, pB1; bf16x8 pa0, pa1, pa2, pa3;
  constexpr int SE = 0, SO = 1;
  SLOAD(SE, 0); asm volatile("s_waitcnt vmcnt(0)" ::: "memory"); SWRITE(0, SE); __syncthreads();
  qkt<ND0, ISB>(pA0, pA1, Kb, qr, r32, hi, kx, qx); partialSM<ISB>(pA0, pA1, mfix);
  SLOAD(SO, KVBLK); SLOAD(SE, 2 * KVBLK);
  SWAIT(); SWRITE(1, SO); __syncthreads();
  int sk = 1, sv = 0, sw = 2;
#define ROT() do { sv = sk; sk = sw; sw = (sw == 2) ? 0 : sw + 1; } while (0)
  for (int j = 1; j + 1 < NT; j += 2) {
    SBAR(); qkt<ND0, ISB>(pB0, pB1, Kb + sk * SHM_K, qr, r32, hi, kx, qx);
    finishSM<!ISB>(pA0, pA1, 1.f, l_reg, pa0, pa1, pa2, pa3); SBAR();
    SLOAD(SO, (j + 2) * KVBLK); SBAR();
    pv_d0(o, vb0 + sv * (int)SHM_V, pa0, pa1, pa2, pa3); RSUM(); partialSM<ISB>(pB0, pB1, mfix);
    SWAIT(); SWRITE(sw, SE);
    __syncthreads(); ROT();
    SBAR(); qkt<ND0, ISB>(pA0, pA1, Kb + sk * SHM_K, qr, r32, hi, kx, qx);
    finishSM<!ISB>(pB0, pB1, 1.f, l_reg, pa0, pa1, pa2, pa3); SBAR();
    if (j + 3 < NT) SLOAD(SE, (j + 3) * KVBLK); SBAR();
    pv_d0(o, vb0 + sv * (int)SHM_V, pa0, pa1, pa2, pa3); RSUM(); partialSM<ISB>(pA0, pA1, mfix);
    SWAIT(); SWRITE(sw, SO);
    __syncthreads(); ROT();
  }
  SBAR(); qkt<ND0, ISB>(pB0, pB1, Kb + sk * SHM_K, qr, r32, hi, kx, qx);
  finishSM<!ISB>(pA0, pA1, 1.f, l_reg, pa0, pa1, pa2, pa3); SBAR();
  pv_d0(o, vb0 + sv * (int)SHM_V, pa0, pa1, pa2, pa3); RSUM(); partialSM<ISB>(pB0, pB1, mfix);
  finishSM<!ISB>(pB0, pB1, 1.f, l_reg, pa0, pa1, pa2, pa3); SBAR();
  pv_d0(o, vb0 + sk * (int)SHM_V, pa0, pa1, pa2, pa3); RSUM();
#undef ROT
#undef RSUM
  float rli[16];
  if constexpr (ISB) {
#pragma unroll
    for (int r = 0; r < 16; ++r) rli[r] = __builtin_amdgcn_rcpf(o5[r]);
  } else {
    if (hi == 0) li_l[r32] = l_reg; asm volatile("s_waitcnt lgkmcnt(0)" ::: "memory");
#pragma unroll
    for (int r = 0; r < 16; ++r) rli[r] = __builtin_amdgcn_rcpf(li_l[crow(r, hi)]);
  }
  const size_t row0 = (size_t)(b * 4096 + qb * 256 + wid * QBLK);
  const int tmap = ISB ? ((vh - 4) & 1) : 0;
  if (ISB && tmap == 0) {
    bf16_t* Ow = O + row0 * LDO + vh * 128;
#pragma unroll
    for (int r = 0; r < 16; ++r) { const int orow = crow(r, hi);
#pragma unroll
      for (int d0 = 0; d0 < 4; ++d0) Ow[(size_t)orow * LDO + d0 * 32 + r32] = (bf16_t)(cvtpk(o[d0][r] * rli[r], 0.f) & 0xffffu); }
  } else {
    __syncthreads();
    bf16_t* tl = (bf16_t*)(lds + wid * 8192);
    const int lrow = lane >> 4, lc = (lane & 15) * 8;
    const bf16_t* te = tl + hi * 4 * 128 + r32;
#pragma unroll
    for (int r = 0; r < 16; ++r)
#pragma unroll
      for (int d0 = 0; d0 < 4; ++d0) o[d0][r] *= rli[r];
    const int gcol = ISB ? 512 + ((vh - 4) >> 1) * 128 : vh * 128;
    if constexpr (ISB) {
      { u32x4 v[8]; const bf16_t* src = O + (row0 + lrow) * LDO + (vh - 1) * 128 + lc;
#pragma unroll
        for (int i = 0; i < 8; ++i) v[i] = *(const u32x4*)(src + (size_t)(4 * i) * LDO);
#pragma unroll
        for (int i = 0; i < 8; ++i) *(u32x4*)(tl + (lrow + 4 * i) * 128 + lc) = v[i]; }
      asm volatile("s_waitcnt lgkmcnt(0)" ::: "memory");
#pragma unroll
      for (int r = 0; r < 16; ++r)
#pragma unroll
        for (int d0 = 0; d0 < 4; ++d0) o[d0][r] = bf2f((short)te[((r & 3) + 8 * (r >> 2)) * 128 + d0 * 32]) - lam * o[d0][r];
      asm volatile("s_waitcnt lgkmcnt(0)" ::: "memory");
    }
    { u32x4 v[8]; const bf16_t* src = P + (row0 + lrow) * LDQ + 1024 + gcol + lc;
#pragma unroll
      for (int i = 0; i < 8; ++i) v[i] = *(const u32x4*)(src + (size_t)(4 * i) * LDQ);
#pragma unroll
      for (int i = 0; i < 8; ++i) *(u32x4*)(tl + (lrow + 4 * i) * 128 + lc) = v[i]; }
    asm volatile("s_waitcnt lgkmcnt(0)" ::: "memory");
    float sg[4];
#pragma unroll
    for (int d0 = 0; d0 < 4; ++d0) sg[d0] = ISB ? subln_g[d0 * 32 + r32] * 0.8f : 1.f;
    bf16_t* Gw = OG + row0 * 1024 + gcol + r32;
#pragma unroll
    for (int r = 0; r < 16; ++r) { const int orow = crow(r, hi); float rs = 1.f;
      if constexpr (ISB) { float ss = (o[0][r] * o[0][r] + o[1][r] * o[1][r]) + (o[2][r] * o[2][r] + o[3][r] * o[3][r]);
        ss += __shfl_xor(ss, 1); ss += __shfl_xor(ss, 2); ss += __shfl_xor(ss, 4); ss += __shfl_xor(ss, 8); ss += __shfl_xor(ss, 16);
        rs = rsqrtf(ss * (1.f / 128.f) + 1e-6f); }
#pragma unroll
      for (int d0 = 0; d0 < 4; ++d0) { const float g = bf2f((short)te[((r & 3) + 8 * (r >> 2)) * 128 + d0 * 32]);
        Gw[(size_t)orow * 1024 + d0 * 32] = (bf16_t)(cvtpk(o[d0][r] * rs * sg[d0] * (g / (1.f + __expf(-g))), 0.f) & 0xffffu); } }
  }
  asm volatile("s_waitcnt vmcnt(0)" ::: "memory");
  __syncthreads();
#undef SLOAD
#undef SWRITE
#undef SWAIT
#undef RESC
}

}

#define LAS __attribute__((address_space(3)))
typedef unsigned short bf16_t;
typedef float f32x4 __attribute__((ext_vector_type(4)));
typedef unsigned u32x4 __attribute__((ext_vector_type(4)));
typedef unsigned u32x2 __attribute__((ext_vector_type(2)));
constexpr int NWAVES = 8, LDS_BYTES = 147456;
constexpr int NLAT = 32768, NCTX = 2048, NROWS = NLAT + NCTX, DM = 1024, NPCOL = 3584, NQCOL = 2048;
constexpr size_t MiB = 1u << 20;
constexpr size_t WS_MODS = 0, WS_ROPEA = 256 * 1024, WS_ROPEB = 288 * 1024, WS_BAR = 512 * 1024, BAR_BYTES = 16384;
constexpr size_t WS_WIN = 1 * MiB, WS_WOUT = 9 * MiB, WS_WFO = 11 * MiB, WS_WFI = 13 * MiB, WS_DFT = 20 * MiB;
constexpr size_t WS_H = 84 * MiB;
constexpr size_t WS_P = 152 * MiB;
constexpr size_t WS_KV = 280 * MiB;
constexpr size_t WS_O = 390 * MiB;
constexpr size_t WS_X1 = WS_P, WS_HS = 280 * MiB  , WS_ZT = 408 * MiB  , WS_SG = WS_H, WS_T = WS_HS  , WS_FG = WS_HS + 64 * MiB, WS_END = 486 * MiB;
constexpr size_t WS_WUB = 37 * MiB, WS_CSM = 39 * MiB;
constexpr size_t WS_EXCH = 40 * MiB;
constexpr int KP = 2176;
static_assert(WS_ZT + (size_t)16384 * KP * 2 <= WS_END && WS_DFT + (size_t)4096 * KP * 2 <= WS_H && WS_O + 96 * MiB <= WS_END && WS_P + (size_t)NLAT * NQCOL * 2 <= WS_KV && WS_KV + (size_t)8 * 12 * 4352 * 128 * 2 <= WS_O && WS_H + (size_t)NROWS * DM * 2 <= WS_P, "ws map");

__device__ __forceinline__ float wave_sum(float v) {
#pragma unroll
    for (int o = 1; o < 64; o <<= 1) v += __shfl_xor(v, o);
    return v;
}
__device__ __forceinline__ unsigned pk2(float lo, float hi) { return pg8::cvt_pk_bf16(lo, hi); }
using pg8::bflo; using pg8::bfhi; using pg8::silu_f;

__device__ __forceinline__ void transpose_item(const float* W, int ldw, int nblk, int K, bf16_t* WT, int row_off, LAS float* scr, int item, int lane) {
    const int kb = item / nblk, nb = item % nblk, k0 = 64 * kb, n0 = 32 * nb;
    float wv[32];
#pragma unroll
    for (int i = 0; i < 32; ++i) wv[i] = __builtin_nontemporal_load(W + (size_t)(k0 + 2 * i + (lane >> 5)) * ldw + n0 + (lane & 31));
#pragma unroll
    for (int i = 0; i < 32; ++i) scr[(2 * i + (lane >> 5)) * 33 + (lane & 31)] = wv[i];
    asm volatile("s_waitcnt lgkmcnt(0)" ::: "memory");
    const int c = lane & 7;
#pragma unroll
    for (int j = 0; j < 4; ++j) { const int n = (lane >> 3) + 8 * j; const LAS float* s = scr + (8 * c) * 33 + n;
        u32x4 o; o.x = pk2(s[0 * 33], s[1 * 33]); o.y = pk2(s[2 * 33], s[3 * 33]); o.z = pk2(s[4 * 33], s[5 * 33]); o.w = pk2(s[6 * 33], s[7 * 33]);
        *(u32x4*)(WT + (size_t)(row_off + n0 + n) * K + k0 + 8 * c) = o; }
    asm volatile("s_waitcnt lgkmcnt(0)" ::: "memory");
}

#define RLX_AGENT __ATOMIC_RELAXED, __HIP_MEMORY_SCOPE_AGENT
#define XB_TMO      128
#define XB_XCNT(j)  (256  + 64 * (j))
#define XB_XSUB(j)  (1280 + 64 * (j))
#define XB_XGEN(j)  (2304 + 64 * (j))
#define XB_TOP      3328
#define XB_TOPGEN   3392
#define XCD_BAR_WORDS 3456
#define XB_SPIN_CAP (1u << 18)

__device__ __forceinline__ unsigned xb_ld(unsigned* p)              { return __hip_atomic_load(p, __ATOMIC_RELAXED, __HIP_MEMORY_SCOPE_AGENT); }
__device__ __forceinline__ unsigned xb_add(unsigned* p, unsigned v) { return __hip_atomic_fetch_add(p, v, __ATOMIC_RELAXED, __HIP_MEMORY_SCOPE_AGENT); }
__device__ __forceinline__ unsigned xb_xcc_id() { return (unsigned)__builtin_amdgcn_s_getreg((3 << 11) | 20) & 0xFu; }
#define XB_SPIN(cond, bar) do { unsigned _sp = 0; while (cond) { __builtin_amdgcn_s_sleep(1); \
    if ((++_sp & 255u) == 0u) { if (xb_ld(&(bar)[XB_TMO])) break; if (_sp > XB_SPIN_CAP) { atomicAdd(&(bar)[XB_TMO], 1u); break; } } } } while (0)

struct XcdBarrier {
    unsigned* bar; unsigned x;
    volatile LAS unsigned* st;
};

__device__ __forceinline__ XcdBarrier xcd_barrier_post(unsigned* bar, volatile LAS unsigned* st) {
    XcdBarrier b; b.bar = bar; b.x = xb_xcc_id(); b.st = st;
    if (threadIdx.x == 0) (void)xb_add(&bar[XB_XCNT(b.x)], 1u);
    return b;
}
__device__ __forceinline__ void xcd_barrier_complete(unsigned* bar, unsigned x, unsigned& nloc, unsigned& nx) {
    const unsigned G = gridDim.x * gridDim.y * gridDim.z;
    unsigned sum, cnt, mine, sp = 0u;
    for (;;) {
        sum = 0u; cnt = 0u; mine = 0u;
#pragma unroll
        for (unsigned j = 0; j < 16; ++j) { const unsigned c = xb_ld(&bar[XB_XCNT(j)]); sum += c; cnt += (c > 0u) ? 1u : 0u; mine = (j == x) ? c : mine; }
        if (sum == G) break;
        __builtin_amdgcn_s_sleep(1);
        if ((++sp & 255u) == 0u) { if (xb_ld(&bar[XB_TMO])) break; if (sp > XB_SPIN_CAP) { atomicAdd(&bar[XB_TMO], 1u); break; } }
    }
    nloc = mine > 0u ? mine : 1u; nx = cnt > 0u ? cnt : 1u;
}

__device__ __forceinline__ void xcd_barrier(const XcdBarrier& b) {
    asm volatile("s_waitcnt vmcnt(0)" ::: "memory");
    __syncthreads();
    if (threadIdx.x == 0) {
        unsigned* bar = b.bar;
        __builtin_amdgcn_s_waitcnt(0);
        unsigned nloc = b.st[0], nx = b.st[1];
        if (nloc == 0u) { xcd_barrier_complete(bar, b.x, nloc, nx); b.st[0] = nloc; b.st[1] = nx; }
        const unsigned old = xb_add(&bar[XB_XSUB(b.x)], 1u);
        const unsigned gen = old / nloc;
        if (old + 1u == (gen + 1u) * nloc) {
            __builtin_amdgcn_fence(__ATOMIC_RELEASE, "agent");
            asm volatile("s_waitcnt vmcnt(0)" ::: "memory");
            const unsigned og = xb_add(&bar[XB_TOP], 1u);
            const unsigned tg = og / nx;
            if (og + 1u == (tg + 1u) * nx) xb_add(&bar[XB_TOPGEN], 1u);
            else XB_SPIN(xb_ld(&bar[XB_TOPGEN]) == tg, bar);
            __builtin_amdgcn_fence(__ATOMIC_ACQUIRE, "agent");
            xb_add(&bar[XB_XGEN(b.x)], 1u);
            asm volatile("s_waitcnt vmcnt(0)" ::: "memory");
        } else {
            XB_SPIN(xb_ld(&bar[XB_XGEN(b.x)]) == gen, bar);
            __builtin_amdgcn_fence(__ATOMIC_ACQUIRE, "agent");
            asm volatile("s_waitcnt vmcnt(0)" ::: "memory");
        }
    }
    __syncthreads();
}


struct Args { const float* in[19]; float* out; unsigned char* ws; int ph_lo, ph_hi; };

__device__ __forceinline__ void p0_prep(const Args& a, unsigned char* lds, int tid, int lane, int wave, int bx, int G) {
    unsigned char* ws = a.ws;
    float* ldsf = (float*)lds;
    float* mods = (float*)(ws + WS_MODS);
    for (int s = bx; s < 192; s += G) {
        const int l = s / 96, j0 = (s % 96) * 32;
        float* sc = ldsf; float* red = ldsf + 9 * 1024;
        for (int i = tid; i < 9 * 1024; i += 512) { const int r = i >> 10, k = i & 1023; const float v = (r < 8) ? a.in[1][r * 1024 + k] : a.in[3][k]; sc[i] = silu_f(v); }
        __syncthreads();
        const int jj = tid & 31, kg = tid >> 5;
        const float* W = a.in[4] + (size_t)l * 1024 * 3072 + j0 + jj;
        float acc[9];
#pragma unroll
        for (int r = 0; r < 9; ++r) acc[r] = 0.f;
#pragma unroll 4
        for (int i = 0; i < 64; ++i) { const int k = kg + 16 * i; const float w = __builtin_nontemporal_load(W + (size_t)k * 3072);
#pragma unroll
            for (int r = 0; r < 9; ++r) acc[r] += sc[r * 1024 + k] * w; }
#pragma unroll
        for (int r = 0; r < 9; ++r) red[(kg * 9 + r) * 32 + jj] = acc[r];
        __syncthreads();
        if (tid < 288) { const int r = tid >> 5, j = tid & 31; float s2 = 0.f;
#pragma unroll
            for (int q = 0; q < 16; ++q) s2 += red[(q * 9 + r) * 32 + j];
            mods[(l * 9 + r) * 3072 + j0 + j] = s2 + a.in[5][l * 3072 + j0 + j]; }
        __syncthreads();
    }
    {
        LAS float* scr = (LAS float*)((LAS unsigned char*)lds + wave * 16384);
        const int gw = bx * NWAVES + wave, NGW = G * NWAVES;
        constexpr int I_IN = 16 * 112, I_SQ = 16 * 32, NITEMS = I_IN + 3 * I_SQ;
        constexpr int EXTRA = 512;
        const int nfree = (G > 192) ? (G - 192) * NWAVES : 0;
        for (int pass = 0; pass < 2; ++pass)
        for (int it = (pass == 0) ? ((bx >= 192 && nfree >= EXTRA) ? (bx - 192) * NWAVES + wave : NITEMS) : ((nfree >= EXTRA ? EXTRA : 0) + gw); it < ((pass == 0) ? EXTRA : NITEMS); it += (pass == 0) ? nfree : NGW) {
            int r = it;
            if (r < I_IN) { transpose_item(a.in[7], 3584, 112, 1024, (bf16_t*)(ws + WS_WIN), 0, scr, r, lane); continue; } r -= I_IN;
            if (r < I_SQ) { transpose_item(a.in[15], 1024, 32, 1024, (bf16_t*)(ws + WS_WOUT), 0, scr, r, lane); continue; } r -= I_SQ;
            if (r < I_SQ) { transpose_item(a.in[17], 1024, 32, 1024, (bf16_t*)(ws + WS_WFO), 0, scr, r, lane); continue; } r -= I_SQ;
            transpose_item(a.in[16] + 1024, 2048, 32, 1024, (bf16_t*)(ws + WS_WFI), 2048, scr, r, lane);
        }
    }
    __syncthreads();
    {
        bf16_t* WuB = (bf16_t*)(ws + WS_WUB); bf16_t* CSm = (bf16_t*)(ws + WS_CSM);
        for (int v = bx * 512 + tid; v < 1024 * 128; v += G * 512) { const int k = v >> 7, c8 = (v & 127) * 8; const float* s = a.in[16] + (size_t)k * 2048 + c8;
            const f32x4 x0 = __builtin_nontemporal_load((const f32x4*)s), x1 = __builtin_nontemporal_load((const f32x4*)(s + 4));
            u32x4 o; o.x = pk2(x0[0], x0[1]); o.y = pk2(x0[2], x0[3]); o.z = pk2(x1[0], x1[1]); o.w = pk2(x1[2], x1[3]);
            *(u32x4*)(WuB + (size_t)k * 1024 + c8) = o; }
        for (int v = bx * 512 + tid; v < 2 * 256 * 32; v += G * 512) { const int cs = v >> 13, n = (v >> 5) & 255, c8 = (v & 31) * 8;
            float e[8];
#pragma unroll
            for (int i = 0; i < 8; ++i) { const float ph = (float)(((c8 + i) * n) & 255) * (1.f / 128.f); e[i] = (cs ? sinpif(ph) : cospif(ph)) * (1.f / 16.f); }
            u32x4 o; o.x = pk2(e[0], e[1]); o.y = pk2(e[2], e[3]); o.z = pk2(e[4], e[5]); o.w = pk2(e[6], e[7]);
            *(u32x4*)(CSm + (size_t)(cs * 1024 + n) * 256 + c8) = o; }
    }
    {
        float* tab = ldsf;
        for (int i = tid; i < 4096; i += 512) tab[i] = cospif((float)i * (1.f / 2048.f)) * (1.f / 64.f);
        __syncthreads();
        bf16_t* Dm = (bf16_t*)(ws + WS_DFT);
        const int total = 4096 * (KP / 8);
        for (int v = bx * 512 + tid; v < total; v += G * 512) {
            const int r = v / (KP / 8), n0 = (v % (KP / 8)) * 8, cs = r >> 11, np = r & 2047, lim = cs ? 2048 : 2049;
            float e[8];
#pragma unroll
            for (int i = 0; i < 8; ++i) e[i] = (n0 + i < lim) ? tab[((n0 + i) * np - 1024 * cs) & 4095] : 0.f;
            u32x4 o; o.x = pk2(e[0], e[1]); o.y = pk2(e[2], e[3]); o.z = pk2(e[4], e[5]); o.w = pk2(e[6], e[7]);
            *(u32x4*)(Dm + (size_t)r * KP + n0) = o;
        }
        __syncthreads();
    }
    if (bx == G - 1) {
        float2* rA = (float2*)(ws + WS_ROPEA); float2* rB = (float2*)(ws + WS_ROPEB);
        for (int i = tid; i < 64 * 32; i += 512) { const int pos = i >> 5, f = i & 31; const float inv = powf(10000.f, -(float)f / 32.f); const float ang = (float)pos * inv; rA[i] = make_float2(cosf(ang), sinf(ang)); }
        for (int i = tid; i < 64 * 16; i += 512) { const int pos = i >> 4, f = i & 15; const float inv = powf(10000.f, -(float)f / 16.f); const float ang = (float)pos * inv; rB[i] = make_float2(cosf(ang), sinf(ang)); }
    }
}

__device__ __forceinline__ void ld_row(const float* xrow, int lane, f32x4 (&v)[4]) {
    const f32x4* xr = (const f32x4*)xrow + lane;
#pragma unroll
    for (int j = 0; j < 4; ++j) v[j] = __builtin_nontemporal_load(xr + 64 * j);
}
__device__ __forceinline__ float row_rstd(const f32x4 (&v)[4]) {
    float s = 0.f;
#pragma unroll
    for (int j = 0; j < 4; ++j) s += (v[j].x * v[j].x + v[j].y * v[j].y) + (v[j].z * v[j].z + v[j].w * v[j].w);
    return rsqrtf(wave_sum(s) * (1.f / DM) + 1e-6f);
}
__device__ __forceinline__ void mod_fin(f32x4 (&y)[4], const float* g, const float* md, int lane) {
    const float rstd = row_rstd(y);
#pragma unroll
    for (int j = 0; j < 4; ++j) { const int col = 4 * (lane + 64 * j);
        const f32x4 gv = *(const f32x4*)(g + col), sh = *(const f32x4*)(md + col), sl = *(const f32x4*)(md + 1024 + col);
        y[j] = y[j] * rstd * gv * (sl + 1.f) + sh; }
}
__device__ __forceinline__ void st_row_bf16(bf16_t* dst, int lane, const f32x4 (&y)[4]) {
    unsigned long long* o8 = (unsigned long long*)dst + lane;
#pragma unroll
    for (int j = 0; j < 4; ++j) o8[64 * j] = (unsigned long long)pk2(y[j].x, y[j].y) | ((unsigned long long)pk2(y[j].z, y[j].w) << 32);
}
__device__ __forceinline__ void mod_params(const float* g, const float* md, int lane, f32x4 (&A)[4], f32x4 (&B)[4]) {
#pragma unroll
    for (int j = 0; j < 4; ++j) { const int col = 4 * (lane + 64 * j); A[j] = *(const f32x4*)(g + col) * (*(const f32x4*)(md + 1024 + col) + 1.f); B[j] = *(const f32x4*)(md + col); }
}
__device__ __forceinline__ void mod_apply(f32x4 (&y)[4], const f32x4 (&A)[4], const f32x4 (&B)[4]) {
    const float rstd = row_rstd(y);
#pragma unroll
    for (int j = 0; j < 4; ++j) y[j] = y[j] * rstd * A[j] + B[j];
}
__device__ __forceinline__ void modulate_rows(const float* X, int nlat, const float* Xc, int nctx, const float* g, const float* mods_l, bf16_t* H, int gw, int NGW, int lane) {
    for (int c = gw; c < nlat / 16; c += NGW) {
        const int r0 = c * 16; f32x4 A[4], B[4]; mod_params(g, mods_l + (r0 >> 12) * 3072, lane, A, B);
        f32x4 va[4][4], vb[4][4];
#define LD4(v, r) do { _Pragma("unroll") for (int i = 0; i < 4; ++i) ld_row(X + (size_t)((r) + i) * DM, lane, v[i]); } while (0)
#define FS4(v, r) do { _Pragma("unroll") for (int i = 0; i < 4; ++i) mod_apply(v[i], A, B); _Pragma("unroll") for (int i = 0; i < 4; ++i) st_row_bf16(H + (size_t)((r) + i) * DM, lane, v[i]); } while (0)
        LD4(va, r0); LD4(vb, r0 + 4); FS4(va, r0); LD4(va, r0 + 8); FS4(vb, r0 + 4); LD4(vb, r0 + 12); FS4(va, r0 + 8); FS4(vb, r0 + 12);
#undef LD4
#undef FS4
    }
    for (int m = gw; m < nctx; m += NGW) { f32x4 v[4]; ld_row(Xc + (size_t)m * DM, lane, v); mod_fin(v, g, mods_l + 8 * 3072, lane); st_row_bf16(H + (size_t)(nlat + m) * DM, lane, v); }
}

__device__ __forceinline__ void modulate_pairs(const float* X, const float* g, const float* mods_l, bf16_t* HS, const bf16_t* WfiT, bf16_t* Zt2, int bx, int wave, int gw, int NGW, int lane) {
    bf16_t* He = HS; bf16_t* Ho = HS + (size_t)16384 * DM; bf16_t* H1 = HS + (size_t)32768 * DM;
    for (int it = gw; it < 2048; it += NGW) {
        const int bq = it >> 8, ch0 = (it & 255) * 4;
        f32x4 y[4]; ld_row(X + (size_t)(bq * 4096 + 2048) * DM, lane, y); mod_fin(y, g, mods_l + bq * 3072, lane);
#pragma unroll
        for (int c = 0; c < 4; ++c) { const int ch = ch0 + c; const u32x2* wp = (const u32x2*)(WfiT + (size_t)ch * DM) + lane; float d = 0.f;
#pragma unroll
            for (int j = 0; j < 4; ++j) { const u32x2 w = wp[64 * j]; d += y[j].x * bflo(w.x) + y[j].y * bfhi(w.x) + y[j].z * bflo(w.y) + y[j].w * bfhi(w.y); }
            d = wave_sum(d);
            unsigned* z0 = (unsigned*)(Zt2 + ((size_t)((bq * 2 + 0) * 1024 + ch)) * KP + 2048) + lane;
            unsigned* z1 = (unsigned*)(Zt2 + ((size_t)((bq * 2 + 1) * 1024 + ch)) * KP + 2048) + lane;
            *z0 = (lane == 0) ? (pk2(d, 0.f) & 0xffffu) : 0u; *z1 = 0u; }
    }
    for (int it0 = gw; it0 < 8 * 2049; it0 += 2 * NGW) {
        f32x4 y[2][2][4]; int bb[2], nn[2];
#pragma unroll
        for (int i = 0; i < 2; ++i) { const int it = min(it0 + i * NGW, 8 * 2049 - 1); bb[i] = it / 2049; nn[i] = it % 2049;
            ld_row(X + (size_t)(bb[i] * 4096 + nn[i]) * DM, lane, y[i][0]); ld_row(X + (size_t)(bb[i] * 4096 + ((4096 - nn[i]) & 4095)) * DM, lane, y[i][1]); }
#pragma unroll
        for (int i = 0; i < 2; ++i) { const float* md = mods_l + bb[i] * 3072; mod_fin(y[i][0], g, md, lane); mod_fin(y[i][1], g, md, lane); }
#pragma unroll
        for (int i = 0; i < 2; ++i) { if (it0 + i * NGW >= 8 * 2049) break;
            const int b = bb[i], n = nn[i];
            st_row_bf16(H1 + (size_t)(b * 4096 + n) * DM, lane, y[i][0]);
            if (n == 0) { st_row_bf16(He + (size_t)(b * 2048) * DM, lane, y[i][0]);
                unsigned long long* o8 = (unsigned long long*)(Ho + (size_t)(b * 2048) * DM) + lane;
#pragma unroll
                for (int j = 0; j < 4; ++j) o8[64 * j] = 0ull; }
            else if (n < 2048) { st_row_bf16(H1 + (size_t)(b * 4096 + 4096 - n) * DM, lane, y[i][1]);
                f32x4 e[4], o[4];
#pragma unroll
                for (int j = 0; j < 4; ++j) { e[j] = y[i][0][j] + y[i][1][j]; o[j] = y[i][0][j] - y[i][1][j]; }
                st_row_bf16(He + (size_t)(b * 2048 + n) * DM, lane, e); st_row_bf16(Ho + (size_t)(b * 2048 + n) * DM, lane, o); }
        }
    }
}
__device__ __forceinline__ void nyquist_rows(const bf16_t* Zt2, const bf16_t* SG, bf16_t* FG, int gw, int NGW, int lane) {
    for (int it0 = gw; it0 < 8192; it0 += 4 * NGW) {
        u32x4 v[4][4]; unsigned short zl[4], sgv[4]; int itv[4];
#pragma unroll
        for (int i = 0; i < 4; ++i) { itv[i] = min(it0 + i * NGW, 8191); const int b = itv[i] >> 10, ch = itv[i] & 1023; const bf16_t* zp = Zt2 + ((size_t)((b * 2) * 1024 + ch)) * KP;
#pragma unroll
            for (int q = 0; q < 4; ++q) v[i][q] = *(const u32x4*)(zp + (q * 64 + lane) * 8);
            zl[i] = zp[2048]; sgv[i] = SG[(size_t)(b * 4096 + 2048) * DM + ch]; }
#pragma unroll
        for (int i = 0; i < 4; ++i) { if (it0 + i * NGW >= 8192) break;
            float s = 0.f;
#pragma unroll
            for (int q = 0; q < 4; ++q) { const u32x4 w = v[i][q]; s += (bflo(w.x) - bfhi(w.x)) + (bflo(w.y) - bfhi(w.y)) + (bflo(w.z) - bfhi(w.z)) + (bflo(w.w) - bfhi(w.w)); }
            s = wave_sum(s) + __uint_as_float(((unsigned)zl[i]) << 16);
            if (lane == 0) { const int b = itv[i] >> 10, ch = itv[i] & 1023; const size_t r = (size_t)(b * 4096 + 2048) * DM + ch;
                FG[r] = (bf16_t)(pk2(s * (1.f / 64.f) * __uint_as_float(((unsigned)sgv[i]) << 16), 0.f) & 0xffffu); } }
    }
}

__device__ __forceinline__ void kpost_rows(bf16_t* KV, const float* kn_g, const float2* ropeA, const float2* ropeB, unsigned* KM, int bx, int G, int wave, int lane, float* ldsf) {
    const int jA = (lane >> 4) & 1, iA = lane & 15, axA = iA >> 3, fbA = (iA & 7) * 4, dA = axA * 64 + fbA;
    const int subB = lane >> 3, iB = lane & 7, axB = iB >> 2, fbB = (iB & 3) * 4, dB = axB * 32 + fbB;
    float gA1[4], gA2[4];
#pragma unroll
    for (int e = 0; e < 4; ++e) { gA1[e] = kn_g[dA + e]; gA2[e] = kn_g[dA + 32 + e]; }
    for (int c = bx; c < 256; c += G) {
        const int b = c >> 5; float kmA = 0.f, kmB = 0.f;
        bf16_t* KA = KV + ((size_t)(b * 12 + jA) * 4352) * 128 + dA;
        bf16_t* KB = KV + ((size_t)(b * 12 + 4 + (subB >> 1)) * 4352) * 128 + (subB & 1) * 64 + dB;
        for (int i0 = 0; i0 < 17; i0 += 4) {
            u32x2 ra1[4], ra2[4], rb1[4], rb2[4]; int ki[4]; float2 csA[4][4], csB[4][4]; u32x2 wa1[4], wa2[4], wb1[4], wb2[4];
#pragma unroll
            for (int i = 0; i < 4; ++i) { ki[i] = (c & 31) * 136 + wave * 17 + min(i0 + i, 16);
                ra1[i] = *(const u32x2*)(KA + (size_t)ki[i] * 128); ra2[i] = *(const u32x2*)(KA + (size_t)ki[i] * 128 + 32);
                rb1[i] = *(const u32x2*)(KB + (size_t)ki[i] * 128); rb2[i] = *(const u32x2*)(KB + (size_t)ki[i] * 128 + 16);
                const int pos_ = (ki[i] - 256) & 4095, prow_ = pos_ >> 6, pcol_ = pos_ & 63;
#pragma unroll
                for (int e = 0; e < 4; ++e) { csA[i][e] = ropeA[(axA ? pcol_ : prow_) * 32 + fbA + e]; csB[i][e] = ropeB[(axB ? pcol_ : prow_) * 16 + fbB + e]; } }
#pragma unroll
            for (int i = 0; i < 4; ++i) { if (i0 + i >= 17) break;
                const int key = ki[i]; const bool lat = key >= 256; const int pos = (key - 256) & 4095, prow = pos >> 6, pcol = pos & 63;
                {
                    float x1[4] = {bflo(ra1[i].x), bfhi(ra1[i].x), bflo(ra1[i].y), bfhi(ra1[i].y)}, x2[4] = {bflo(ra2[i].x), bfhi(ra2[i].x), bflo(ra2[i].y), bfhi(ra2[i].y)};
                    float ss = 0.f;
#pragma unroll
                    for (int e = 0; e < 4; ++e) ss += x1[e] * x1[e] + x2[e] * x2[e];
                    ss += __shfl_xor(ss, 1); ss += __shfl_xor(ss, 2); ss += __shfl_xor(ss, 4); ss += __shfl_xor(ss, 8);
                    const float rstd = rsqrtf(ss * (1.f / 128.f) + 1e-6f);
                    const int pa = axA ? pcol : prow; float s2 = 0.f;
#pragma unroll
                    for (int e = 0; e < 4; ++e) { float a1 = x1[e] * rstd * gA1[e], a2 = x2[e] * rstd * gA2[e]; s2 += a1 * a1 + a2 * a2;
                        if (lat) { const float2 cs = csA[i][e]; const float t1 = a1 * cs.x - a2 * cs.y, t2 = a1 * cs.y + a2 * cs.x; a1 = t1; a2 = t2; }
                        x1[e] = a1; x2[e] = a2; }
                    s2 += __shfl_xor(s2, 1); s2 += __shfl_xor(s2, 2); s2 += __shfl_xor(s2, 4); s2 += __shfl_xor(s2, 8);
                    kmA = fmaxf(kmA, s2);
                    wa1[i].x = pk2(x1[0], x1[1]); wa1[i].y = pk2(x1[2], x1[3]); wa2[i].x = pk2(x2[0], x2[1]); wa2[i].y = pk2(x2[2], x2[3]);
                }
                {
                    float x1[4] = {bflo(rb1[i].x), bfhi(rb1[i].x), bflo(rb1[i].y), bfhi(rb1[i].y)}, x2[4] = {bflo(rb2[i].x), bfhi(rb2[i].x), bflo(rb2[i].y), bfhi(rb2[i].y)};
                    float s2 = 0.f;
#pragma unroll
                    for (int e = 0; e < 4; ++e) s2 += x1[e] * x1[e] + x2[e] * x2[e];
                    s2 += __shfl_xor(s2, 1); s2 += __shfl_xor(s2, 2); s2 += __shfl_xor(s2, 4);
                    kmB = fmaxf(kmB, s2);
                    if (lat) {
#pragma unroll
                        for (int e = 0; e < 4; ++e) { const float2 cs = csB[i][e]; const float t1 = x1[e] * cs.x - x2[e] * cs.y, t2 = x1[e] * cs.y + x2[e] * cs.x; x1[e] = t1; x2[e] = t2; }
                    }
                    wb1[i].x = pk2(x1[0], x1[1]); wb1[i].y = pk2(x1[2], x1[3]); wb2[i].x = pk2(x2[0], x2[1]); wb2[i].y = pk2(x2[2], x2[3]);
                }
            }
#pragma unroll
            for (int i = 0; i < 4; ++i) { if (i0 + i >= 17) break;
                const int key = ki[i];
                if (lane < 32) { *(u32x2*)(KA + (size_t)key * 128) = wa1[i]; *(u32x2*)(KA + (size_t)key * 128 + 32) = wa2[i]; }
                if (key >= 256) { *(u32x2*)(KB + (size_t)key * 128) = wb1[i]; *(u32x2*)(KB + (size_t)key * 128 + 16) = wb2[i]; } }
        }
        __syncthreads();
        if (lane == 0 || lane == 16) ldsf[wave * 10 + (lane >> 4)] = kmA;
        if ((lane & 7) == 0) ldsf[wave * 10 + 2 + subB] = kmB;
        __syncthreads();
        if (threadIdx.x < 10) { float v = 0.f;
#pragma unroll
            for (int w = 0; w < NWAVES; ++w) v = fmaxf(v, ldsf[w * 10 + threadIdx.x]);
            __hip_atomic_fetch_max(KM + b * 16 + threadIdx.x, __float_as_uint(v), __ATOMIC_RELAXED, __HIP_MEMORY_SCOPE_AGENT); }
    }
}

__device__ __forceinline__ void og_rows(const bf16_t* O, const bf16_t* P, const Args& a, bf16_t* OG, int gw, int NGW, int lane) {
    const float s1 = wave_sum(a.in[10][lane] * a.in[11][lane]), s2 = wave_sum(a.in[12][lane] * a.in[13][lane]);
    const float lam = expf(s1) - expf(s2) + 0.2f;
    const int h = lane >> 4, e0 = (lane & 15) * 8;
    float sg8[8];
#pragma unroll
    for (int e = 0; e < 8; ++e) sg8[e] = a.in[14][e0 + e] * 0.8f;
    for (int m0 = gw; m0 < NLAT; m0 += 2 * NGW) {
        u32x4 ovA[2], gvA[2], o1B[2], o2B[2], gvB[2]; int mi[2];
#pragma unroll
        for (int i = 0; i < 2; ++i) { mi[i] = min(m0 + i * NGW, NLAT - 1);
            const bf16_t* orow = O + (size_t)mi[i] * 1536; const bf16_t* grow = P + (size_t)mi[i] * NQCOL + 1024;
            ovA[i] = *(const u32x4*)(orow + 8 * lane); gvA[i] = *(const u32x4*)(grow + 8 * lane);
            o1B[i] = *(const u32x4*)(orow + 512 + (2 * h) * 128 + e0); o2B[i] = *(const u32x4*)(orow + 512 + (2 * h + 1) * 128 + e0); gvB[i] = *(const u32x4*)(grow + 512 + h * 128 + e0); }
#pragma unroll
        for (int i = 0; i < 2; ++i) { if (m0 + i * NGW >= NLAT) break;
            bf16_t* out = OG + (size_t)mi[i] * DM;
            {
                const u32x4 ov = ovA[i], gv = gvA[i];
                u32x4 w; w.x = pk2(bflo(ov.x) * silu_f(bflo(gv.x)), bfhi(ov.x) * silu_f(bfhi(gv.x))); w.y = pk2(bflo(ov.y) * silu_f(bflo(gv.y)), bfhi(ov.y) * silu_f(bfhi(gv.y)));
                w.z = pk2(bflo(ov.z) * silu_f(bflo(gv.z)), bfhi(ov.z) * silu_f(bfhi(gv.z))); w.w = pk2(bflo(ov.w) * silu_f(bflo(gv.w)), bfhi(ov.w) * silu_f(bfhi(gv.w)));
                *(u32x4*)(out + 8 * lane) = w;
            }
            {
                const u32x4 o1 = o1B[i], o2 = o2B[i], gv = gvB[i];
                float d[8] = {bflo(o1.x) - lam * bflo(o2.x), bfhi(o1.x) - lam * bfhi(o2.x), bflo(o1.y) - lam * bflo(o2.y), bfhi(o1.y) - lam * bfhi(o2.y),
                              bflo(o1.z) - lam * bflo(o2.z), bfhi(o1.z) - lam * bfhi(o2.z), bflo(o1.w) - lam * bflo(o2.w), bfhi(o1.w) - lam * bfhi(o2.w)};
                float gg[8] = {bflo(gv.x), bfhi(gv.x), bflo(gv.y), bfhi(gv.y), bflo(gv.z), bfhi(gv.z), bflo(gv.w), bfhi(gv.w)};
                float ss = 0.f;
#pragma unroll
                for (int e = 0; e < 8; ++e) ss += d[e] * d[e];
                ss += __shfl_xor(ss, 1); ss += __shfl_xor(ss, 2); ss += __shfl_xor(ss, 4); ss += __shfl_xor(ss, 8);
                const float rstd = rsqrtf(ss * (1.f / 128.f) + 1e-6f);
                float y[8];
#pragma unroll
                for (int e = 0; e < 8; ++e) y[e] = d[e] * rstd * sg8[e] * silu_f(gg[e]);
                u32x4 w; w.x = pk2(y[0], y[1]); w.y = pk2(y[2], y[3]); w.z = pk2(y[4], y[5]); w.w = pk2(y[6], y[7]);
                *(u32x4*)(out + 512 + h * 128 + e0) = w;
            }
        }
    }
}

__device__ __forceinline__ void final_norm_rows(float* out, const float* g, int gw, int NGW, int lane) {
    for (int m = gw; m < NLAT; m += 4 * NGW) {
        f32x4 v[4][4]; int mi[4];
#pragma unroll
        for (int i = 0; i < 4; ++i) { mi[i] = min(m + i * NGW, NLAT - 1); ld_row(out + (size_t)mi[i] * DM, lane, v[i]); }
#pragma unroll
        for (int i = 0; i < 4; ++i) { if (m + i * NGW >= NLAT) break;
            const float rstd = row_rstd(v[i]); f32x4* xr = (f32x4*)(out + (size_t)mi[i] * DM) + lane;
#pragma unroll
            for (int j = 0; j < 4; ++j) { const f32x4 gv = *(const f32x4*)(g + 4 * (lane + 64 * j)); xr[64 * j] = v[i][j] * rstd * gv; } }
    }
}

constexpr int N_PHASES = 12;
#ifndef MK_N_LAUNCHES
#define MK_N_LAUNCHES 1
#endif

__global__ void __launch_bounds__(NWAVES * 64, 2) mk_fwd(Args a) {
    extern __shared__ __attribute__((aligned(16))) unsigned char lds[];
    cg::grid_group grid = cg::this_grid();
    const int tid = threadIdx.x, lane = tid & 63, wave = __builtin_amdgcn_readfirstlane(tid >> 6);
    const int G = gridDim.x, bx = blockIdx.x, gw = bx * NWAVES + wave, NGW = G * NWAVES;
    unsigned char* ws = a.ws;
    const int lo = a.ph_lo, hi = a.ph_hi;
    float* mods = (float*)(ws + WS_MODS);
    const float2* ropeA = (const float2*)(ws + WS_ROPEA); const float2* ropeB = (const float2*)(ws + WS_ROPEB);
    bf16_t* H = (bf16_t*)(ws + WS_H); bf16_t* P = (bf16_t*)(ws + WS_P); bf16_t* O = (bf16_t*)(ws + WS_O); bf16_t* KVc = (bf16_t*)(ws + WS_KV);
    float* X1 = (float*)(ws + WS_X1); bf16_t* Zt = (bf16_t*)(ws + WS_ZT); bf16_t* SG = (bf16_t*)(ws + WS_SG);
    bf16_t* HS = (bf16_t*)(ws + WS_HS); bf16_t* FG = (bf16_t*)(ws + WS_FG); bf16_t* T = (bf16_t*)(ws + WS_T);
    PG8_LAS unsigned char* ldsl = (PG8_LAS unsigned char*)lds;
    volatile LAS unsigned* bst = (volatile LAS unsigned*)((LAS unsigned char*)lds + 131072 + 64);
    if (tid < 4) bst[tid] = 0u;
    __syncthreads();
    XcdBarrier bar; bar.bar = (unsigned*)(ws + WS_BAR); bar.x = 0; bar.st = bst;
    if (hi - lo > 1) {
        bar.x = xb_xcc_id();
        if (tid == 0) bst[2] = xb_add(&bar.bar[XB_XCNT(bar.x)], 1u);
    }
    int vcu = bx;
#define IN(k) (lo <= (k) && (k) < hi)
#define SEAM(k) do { if (IN(k) && IN((k) + 1)) xcd_barrier(bar); } while (0)
    if (lo > hi) grid.sync();
    typedef pg8::StaticOrder SO;

    if (IN(0)) p0_prep(a, lds, tid, lane, wave, bx, G);
    SEAM(0);
    if (IN(0) && IN(1) && G == 256) {
        if (tid == 0) { unsigned ok = (bar.x < 8u) ? 1u : 0u;
            for (unsigned j = 0; j < 16; ++j) { const unsigned c = xb_ld(&bar.bar[XB_XCNT(j)]); ok &= (c == (j < 8u ? 32u : 0u)) ? 1u : 0u; }
            bst[3] = ok; }
        __syncthreads();
        if (bst[3]) vcu = __builtin_amdgcn_readfirstlane((int)(bar.x + 8u * bst[2]));
    }
    if (IN(1)) {
        if (bx < 32) {
            const int g_ = bx >> 3, cs_ = (bx >> 2) & 1, pn_ = bx & 3;
            pg8::Gemm gm{(const bf16_t*)(ws + WS_CSM), (const bf16_t*)(ws + WS_WUB) + g_ * 256, 256, DM, 2048, DM, 256, -1, 0, 0, 0};
            pg8::OneUnit S1{cs_ * 4, pn_, 1};
            pg8::EpiPlain E1{(bf16_t*)(ws + WS_WFI) + (size_t)(g_ * 256) * DM, DM};
            pg8::gemm_phase<pg8::EpiPlain, pg8::OneUnit, true, true>(ldsl, gm, S1, E1);
        }
        modulate_rows(a.in[0], NLAT, a.in[2], NCTX, a.in[6], mods, H, gw, NGW, lane);
    }
    SEAM(1);
    if (IN(2)) {
        pg8::Gemm g{H, (const bf16_t*)(ws + WS_WIN), DM, DM, NROWS, NPCOL, DM, -1, 0, 0, 0}; SO S; S.init(NROWS, NPCOL, G, vcu);
        pg8::EpiInProj E{KVc, P};
        pg8::gemm_phase<pg8::EpiInProj, SO, true, true>(ldsl, g, S, E);
    }
    SEAM(2);
    unsigned* KM = (unsigned*)(ws + WS_BAR + 15360);
    if (IN(3)) kpost_rows(KVc, a.in[9], ropeA, ropeB, KM, bx, G, wave, lane, (float*)lds);
    SEAM(3);
    if (IN(4)) {
        const float s1 = wave_sum(a.in[10][lane] * a.in[11][lane]), s2 = wave_sum(a.in[12][lane] * a.in[13][lane]);
        const float lam = expf(s1) - expf(s2) + 0.2f;
        const int nA = (vcu < 512) ? (512 - vcu + G - 1) / G : 0;
        for (int k = 0; ; ++k) {
            const bool isA = k < nA; const int kb = k - nA;
            const int u = isA ? vcu + k * G : vcu + (kb >> 1) * G;
            if (!isA && u >= 512) break;
            const int round = u >> 8, w = u & 255, xcd = w & 7, slot = w >> 3, qb = slot & 15;
            if (isA) { const int pair = round * 8 + xcd, b = pair >> 1, kvh = pair & 1, vh = kvh * 2 + (slot >> 4);
                att::attn_unit<false>(P, KVc, O, H, lam, a.in[14], b, vh, qb, a.in[8], ropeA, ropeB, KM, (char*)lds); }
            else { const int t_ = kb & 1, head_ = (round * 8 + xcd) * 2 + (slot >> 4), b = head_ >> 2, h = head_ & 3, vh = 4 + 2 * h + t_;
                att::attn_unit<true>(P, KVc, O, H, lam, a.in[14], b, vh, qb, a.in[8], ropeA, ropeB, KM, (char*)lds); }
        }
    }
    SEAM(4);
    if (IN(6)) {
        pg8::Gemm g{H, (const bf16_t*)(ws + WS_WOUT), DM, DM, NLAT, DM, DM, -1, 0, 0, 0}; SO S; S.init(NLAT, DM, G, vcu);
        pg8::EpiResid E{a.in[0], X1, mods + 2048};
        pg8::gemm_phase<pg8::EpiResid, SO, true, true>(ldsl, g, S, E);
    }
    SEAM(6);
    if (IN(7)) modulate_pairs(X1, a.in[6] + DM, mods + 9 * 3072, HS, (const bf16_t*)(ws + WS_WFI), Zt, bx, wave, gw, NGW, lane);
    SEAM(7);
    if (IN(8)) {
        pg8::Gemm g{HS, (const bf16_t*)(ws + WS_WFI), DM, DM, 65536, DM, DM, -1, 6, 4, 2}; SO S; S.init(65536, DM, G, vcu);
        pg8::EpiFin E{Zt, SG};
        pg8::gemm_phase<pg8::EpiFin, SO, true, true>(ldsl, g, S, E);
    }
    SEAM(8);
    if (IN(9)) {
        nyquist_rows(Zt, SG, FG, gw, NGW, lane);
        pg8::Gemm g{(const bf16_t*)(ws + WS_DFT), Zt, KP, KP, 4096, 16384, KP, -1, 0, 0, 0}; pg8::PairOrder S{G, vcu};
        pg8::EpiDft E{SG, FG, T};
        pg8::gemm_phase<pg8::EpiDft, pg8::PairOrder, true, true>(ldsl, g, S, E);
    }
    SEAM(9);
    if (IN(10)) {
        pg8::Gemm g{FG, (const bf16_t*)(ws + WS_WFO), DM, DM, NLAT, DM, DM, -1, 0, 0, 0}; SO S; S.init(NLAT, DM, G, vcu);
        if (G == 256) {
            pg8::EpiFinal E{X1, a.out, mods + 9 * 3072 + 2048, a.in[18], (unsigned*)(ws + WS_EXCH), (unsigned*)(ws + WS_BAR + 15872), (PG8_LAS float*)(ldsl + 131072 + 1024)};
            pg8::gemm_phase<pg8::EpiFinal, SO, true, true>(ldsl, g, S, E);
        } else {
            pg8::EpiResid E{X1, a.out, mods + 9 * 3072 + 2048};
            pg8::gemm_phase<pg8::EpiResid, SO, true, true>(ldsl, g, S, E);
        }
    }
    if (G != 256) { SEAM(10); if (IN(11)) final_norm_rows(a.out, a.in[18], gw, NGW, lane); }
#undef IN
#undef SEAM
}

extern "C" void kernel_launch(void* const* d_in, const int* in_sizes, int n_in, void* d_out, int out_size, void* d_ws, size_t ws_size, hipStream_t stream) {
    static int grid = 0;
    if (grid == 0) {
        if (n_in != 19 || in_sizes[0] != NLAT * DM || out_size != NLAT * DM || ws_size < WS_END) {
            fprintf(stderr, "kernel_launch: unexpected shapes: n_in %d in0 %d out %d ws %zu (need >= %zu)\n", n_in, n_in > 0 ? in_sizes[0] : -1, out_size, ws_size, (size_t)WS_END); grid = -1; return; }
        int dev = 0, cus = 0, per_cu = 0;
        if (hipGetDevice(&dev) != hipSuccess || hipDeviceGetAttribute(&cus, hipDeviceAttributeMultiprocessorCount, dev) != hipSuccess) { grid = -1; return; }
        if (hipFuncSetAttribute((const void*)mk_fwd, hipFuncAttributeMaxDynamicSharedMemorySize, LDS_BYTES) != hipSuccess) { fprintf(stderr, "kernel_launch: hipFuncSetAttribute failed\n"); grid = -1; return; }
        if (hipOccupancyMaxActiveBlocksPerMultiprocessor(&per_cu, (const void*)mk_fwd, NWAVES * 64, LDS_BYTES) != hipSuccess || per_cu < 1) { fprintf(stderr, "kernel_launch: occupancy query gave %d\n", per_cu); per_cu = 1; }
        (void)hipGetLastError();
        grid = cus * 1;
    }
    if (grid < 0) return;
    Args a{};
    for (int i = 0; i < 19; ++i) a.in[i] = (const float*)d_in[i];
    a.out = (float*)d_out; a.ws = (unsigned char*)d_ws;
#if MK_N_LAUNCHES == 1
    if (hipMemsetAsync((unsigned char*)d_ws + WS_BAR, 0, BAR_BYTES, stream) != hipSuccess) { fprintf(stderr, "kernel_launch: memset failed\n"); return; }
    a.ph_lo = 0; a.ph_hi = N_PHASES;
    void* args[] = {&a};
    hipError_t e = hipLaunchCooperativeKernel((const void*)mk_fwd, dim3(grid), dim3(NWAVES * 64), args, LDS_BYTES, stream);
    if (e != hipSuccess) fprintf(stderr, "kernel_launch: cooperative launch failed: %s (grid %d)\n", hipGetErrorString(e), grid);
#else
    for (int p = 0; p < N_PHASES; ++p) {
        a.ph_lo = p; a.ph_hi = p + 1;
        hipLaunchKernelGGL(mk_fwd, dim3(grid), dim3(NWAVES * 64), LDS_BYTES, stream, a);
    }
    const hipError_t le = hipPeekAtLastError();
    if (le != hipSuccess) fprintf(stderr, "kernel_launch: launch failed: %s\n", hipGetErrorName(le));
#endif
}
```
